# Optimizing an MI355X kernel written in HIP

```python
import jax, jax.numpy as jnp
from jax import lax
import numpy as np

D_MODEL = 1024
BATCH = 1
SEQ = 16384
DEPTH = 4

MLA_HEADS = 8
QK_NOPE_DIM = 128
QK_ROPE_DIM = 64
V_HEAD_DIM = 128
Q_LORA_RANK = 384
KV_LORA_RANK = 256
ROPE_THETA = 10000.0
Q_BLOCK = 128
FOURIER_GROUPS = 4
FOURIER_GROUP_DIM = 128
FOURIER_WIDTH = FOURIER_GROUPS * FOURIER_GROUP_DIM
EVEN_IN_WIDTH = Q_LORA_RANK + KV_LORA_RANK + QK_ROPE_DIM + FOURIER_WIDTH
EVEN_MIX_WIDTH = MLA_HEADS * V_HEAD_DIM + FOURIER_WIDTH
SGU_CHUNK = 128
SGU_GROUPS = 8
SGU_WIDTH = 2 * D_MODEL
SGU_GROUP_DIM = SGU_WIDTH // SGU_GROUPS
D_FF = ((8 * D_MODEL + 3 * 256 - 1) // (3 * 256)) * 256
N_EVEN = (DEPTH + 1) // 2
N_ODD = DEPTH // 2
DN_ALPHA = (2 * DEPTH) ** 0.25
DN_BETA = (8 * DEPTH) ** -0.25
LN_EPS = 1e-5
RMS_EPS = 1e-6

kernel_name = "hybrid_mla_fnet_sgu_deepnorm_encoder"


def layer_norm(x, g, b):
    xf = x.astype(jnp.float32)
    mu = jnp.mean(xf, axis=-1, keepdims=True)
    var = jnp.mean(jnp.square(xf - mu), axis=-1, keepdims=True)
    return ((xf - mu) * lax.rsqrt(var + LN_EPS) * g + b).astype(x.dtype)


def rms_norm(x, g):
    xf = x.astype(jnp.float32)
    ms = jnp.mean(jnp.square(xf), axis=-1, keepdims=True)
    return (xf * lax.rsqrt(ms + RMS_EPS) * g).astype(x.dtype)


def rotary_tables(seq):
    inv = 1.0 / (ROPE_THETA ** (jnp.arange(0, QK_ROPE_DIM, 2, dtype=jnp.float32) / QK_ROPE_DIM))
    ang = jnp.arange(seq, dtype=jnp.float32)[:, None] * inv[None, :]
    return jnp.cos(ang), jnp.sin(ang)


def apply_rotary(t, cos, sin):
    tf = t.astype(jnp.float32)
    t1, t2 = jnp.split(tf, 2, axis=-1)
    return jnp.concatenate([t1 * cos - t2 * sin, t1 * sin + t2 * cos], axis=-1).astype(t.dtype)


def mla_attention(q_nope, q_rope, k_nope, k_rope, v):
    B, S, H, _ = q_nope.shape
    nb = S // Q_BLOCK
    scale = (QK_NOPE_DIM + QK_ROPE_DIM) ** -0.5

    def to_blocks(t):
        return jnp.moveaxis(t.reshape(B, nb, Q_BLOCK, *t.shape[2:]), 1, 0)

    def attend(blk):
        qn, qr = blk
        s = (jnp.einsum('bqhd,bkhd->bhqk', qn, k_nope, preferred_element_type=jnp.float32)
             + jnp.einsum('bqhr,bkr->bhqk', qr, k_rope, preferred_element_type=jnp.float32))
        p = jax.nn.softmax(s * scale, axis=-1)
        return jnp.einsum('bhqk,bkhd->bqhd', p.astype(v.dtype), v)

    out = lax.map(attend, (to_blocks(q_nope), to_blocks(q_rope)))
    return jnp.moveaxis(out, 0, 1).reshape(B, S, H * V_HEAD_DIM)


def fourier_mix(f):
    B, S, _ = f.shape
    fg = f.astype(jnp.float32).reshape(B, S, FOURIER_GROUPS, FOURIER_GROUP_DIM)
    y = jnp.fft.fft2(fg, axes=(1, 3), norm="ortho").real
    return y.reshape(B, S, FOURIER_WIDTH).astype(f.dtype)


def even_mixer(x, w_in, q_norm, w_uq, kv_norm, w_uk, w_uv, w_out, cos, sin):
    B, S, _ = x.shape
    h = x @ w_in
    c_q, c_kv, k_r, f = jnp.split(
        h, [Q_LORA_RANK, Q_LORA_RANK + KV_LORA_RANK, Q_LORA_RANK + KV_LORA_RANK + QK_ROPE_DIM], axis=-1)
    q = (rms_norm(c_q, q_norm) @ w_uq).reshape(B, S, MLA_HEADS, QK_NOPE_DIM + QK_ROPE_DIM)
    q_nope = q[..., :QK_NOPE_DIM]
    q_rope = apply_rotary(q[..., QK_NOPE_DIM:], cos[:, None, :], sin[:, None, :])
    c_kv = rms_norm(c_kv, kv_norm)
    k_nope = (c_kv @ w_uk).reshape(B, S, MLA_HEADS, QK_NOPE_DIM)
    v = (c_kv @ w_uv).reshape(B, S, MLA_HEADS, V_HEAD_DIM)
    k_rope = apply_rotary(k_r, cos, sin)
    attn = mla_attention(q_nope, q_rope, k_nope, k_rope, v)
    return jnp.concatenate([attn, fourier_mix(f)], axis=-1) @ w_out


def odd_mixer(x, w_in, norm_g, norm_b, w_s, b_s, w_out):
    B, S, _ = x.shape
    z = jax.nn.gelu(x @ w_in, approximate=False)
    u, v = jnp.split(z, 2, axis=-1)
    v = layer_norm(v, norm_g, norm_b)
    vc = v.reshape(B, S // SGU_CHUNK, SGU_CHUNK, SGU_GROUPS, SGU_GROUP_DIM)
    s = (jnp.einsum('gpq,bnqgc->bnpgc', w_s, vc)
         + jnp.swapaxes(b_s, 0, 1)[None, None, :, :, None])
    return (u * s.reshape(B, S, SGU_WIDTH)) @ w_out


def swiglu(x, w_gate, w_up, w_down):
    return (jax.nn.silu(x @ w_gate) * (x @ w_up)) @ w_down


def setup_inputs(seed: int = 0) -> dict:
    key = jax.random.key(seed)
    ks = jax.random.split(key, 24)

    def nrm(k, shape, scale):
        return jax.random.normal(k, shape, jnp.float32) * scale

    def gain(k, shape):
        return 1.0 + 0.02 * jax.random.normal(k, shape, jnp.float32)

    def small(k, shape):
        return 0.02 * jax.random.normal(k, shape, jnp.float32)

    E, O, L = N_EVEN, N_ODD, DEPTH
    return {
        "x": jax.random.normal(ks[0], (BATCH, SEQ, D_MODEL), jnp.float32),
        "even_w_in": nrm(ks[1], (E, D_MODEL, EVEN_IN_WIDTH), D_MODEL ** -0.5),
        "even_q_norm": gain(ks[2], (E, Q_LORA_RANK)),
        "even_w_uq": nrm(ks[3], (E, Q_LORA_RANK, MLA_HEADS * (QK_NOPE_DIM + QK_ROPE_DIM)), Q_LORA_RANK ** -0.5),
        "even_kv_norm": gain(ks[4], (E, KV_LORA_RANK)),
        "even_w_uk": nrm(ks[5], (E, KV_LORA_RANK, MLA_HEADS * QK_NOPE_DIM), KV_LORA_RANK ** -0.5),
        "even_w_uv": nrm(ks[6], (E, KV_LORA_RANK, MLA_HEADS * V_HEAD_DIM), KV_LORA_RANK ** -0.5 * DN_BETA),
        "even_w_out": nrm(ks[7], (E, EVEN_MIX_WIDTH, D_MODEL), EVEN_MIX_WIDTH ** -0.5 * DN_BETA),
        "odd_w_in": nrm(ks[8], (O, D_MODEL, 2 * SGU_WIDTH), D_MODEL ** -0.5),
        "odd_sgu_norm_g": gain(ks[9], (O, SGU_WIDTH)),
        "odd_sgu_norm_b": small(ks[10], (O, SGU_WIDTH)),
        "odd_w_spatial": nrm(ks[11], (O, SGU_GROUPS, SGU_CHUNK, SGU_CHUNK), SGU_CHUNK ** -0.5),
        "odd_b_spatial": gain(ks[12], (O, SGU_GROUPS, SGU_CHUNK)),
        "odd_w_out": nrm(ks[13], (O, SGU_WIDTH, D_MODEL), SGU_WIDTH ** -0.5 * DN_BETA),
        "mix_ln_g": gain(ks[14], (L, D_MODEL)),
        "mix_ln_b": small(ks[15], (L, D_MODEL)),
        "ffn_w_gate": nrm(ks[16], (L, D_MODEL, D_FF), D_MODEL ** -0.5),
        "ffn_w_up": nrm(ks[17], (L, D_MODEL, D_FF), D_MODEL ** -0.5 * DN_BETA),
        "ffn_w_down": nrm(ks[18], (L, D_FF, D_MODEL), D_FF ** -0.5 * DN_BETA),
        "ffn_ln_g": gain(ks[19], (L, D_MODEL)),
        "ffn_ln_b": small(ks[20], (L, D_MODEL)),
    }


def reference(x, even_w_in, even_q_norm, even_w_uq, even_kv_norm, even_w_uk, even_w_uv, even_w_out,
              odd_w_in, odd_sgu_norm_g, odd_sgu_norm_b, odd_w_spatial, odd_b_spatial, odd_w_out,
              mix_ln_g, mix_ln_b, ffn_w_gate, ffn_w_up, ffn_w_down, ffn_ln_g, ffn_ln_b):
    cos, sin = rotary_tables(x.shape[1])
    for layer in range(DEPTH):
        i = layer // 2
        if layer % 2 == 0:
            y = even_mixer(x, even_w_in[i], even_q_norm[i], even_w_uq[i], even_kv_norm[i],
                           even_w_uk[i], even_w_uv[i], even_w_out[i], cos, sin)
        else:
            y = odd_mixer(x, odd_w_in[i], odd_sgu_norm_g[i], odd_sgu_norm_b[i],
                          odd_w_spatial[i], odd_b_spatial[i], odd_w_out[i])
        x = layer_norm(DN_ALPHA * x + y, mix_ln_g[layer], mix_ln_b[layer])
        x = layer_norm(DN_ALPHA * x + swiglu(x, ffn_w_gate[layer], ffn_w_up[layer], ffn_w_down[layer]),
                       ffn_ln_g[layer], ffn_ln_b[layer])
    return x
```

```cpp
#include <hip/hip_runtime.h>
#include <hip/hip_cooperative_groups.h>
#include <cstdio>
#include <cstdint>
#include <cmath>
namespace cg = cooperative_groups;

#define LAS __attribute__((address_space(3)))
typedef unsigned short bf16_t;
typedef short bf16x8 __attribute__((ext_vector_type(8)));
typedef short s16x4 __attribute__((ext_vector_type(4)));
typedef float f32x4 __attribute__((ext_vector_type(4)));
typedef float f32x2 __attribute__((ext_vector_type(2)));
typedef float f32x16 __attribute__((ext_vector_type(16)));
typedef unsigned u32x4 __attribute__((ext_vector_type(4)));
typedef unsigned u32x2 __attribute__((ext_vector_type(2)));
typedef _Float16 h16x4 __attribute__((ext_vector_type(4)));
typedef int v8i __attribute__((ext_vector_type(8)));
typedef _Float16 h16x2 __attribute__((ext_vector_type(2)));
typedef _Float16 h16x8 __attribute__((ext_vector_type(8)));

constexpr int S = 16384, DM = 1024, DFF = 2816;
constexpr float DN_ALPHA = 1.6817928305074290f;
constexpr float LN_EPS = 1e-5f, RMS_EPS = 1e-6f;
constexpr int NW = 8;

constexpr size_t MiB = 1u << 20;
constexpr size_t WS_FTAB = 7 * MiB, WS_ROPEC = 1 * MiB, WS_ROPES = 3 * MiB, WS_TW = 5 * MiB, WS_FST = 5 * MiB + 256 * 1024;
constexpr size_t WS_WMIX = 8 * MiB, WS_WFFN = 24 * MiB, WS_XB = 42 * MiB, WS_ACT = 74 * MiB;
constexpr size_t WE_INN = 0, WE_INF = (3 * MiB) / 2, WE_Q = (7 * MiB) / 2, WE_KV = 5 * MiB, WE_OUTA = 6 * MiB, WE_OUTF = 8 * MiB;
constexpr size_t WO_IN = 0, WO_SP = 8 * MiB, WO_OUT = 9 * MiB;
constexpr size_t WF_GU = 0, WF_DN = 11 * MiB;
constexpr size_t A_Q = 24 * MiB, A_HBUF = 0, A_KV = 48 * MiB, A_ZT = 80 * MiB, A_KR = 112 * MiB, A_AP = 114 * MiB, A_ATTNO = 114 * MiB,
                 A_CQN = 146 * MiB, A_CKVN = 158 * MiB, A_MIXF = 166 * MiB, A_HMID = 0, A_U = 0, A_VT = 64 * MiB, A_K8 = 48 * MiB, A_V8T = 64 * MiB, A_XHM = 146 * MiB;
constexpr size_t WS_END = 256 * MiB;
constexpr size_t WS_MIX = WS_XB;

__device__ __forceinline__ unsigned cvt_pk_bf16(float lo, float hi) { unsigned r; asm volatile("v_cvt_pk_bf16_f32 %0, %1, %2" : "=v"(r) : "v"(lo), "v"(hi)); return r; }
__device__ __forceinline__ unsigned cvt_pk_f16(float lo, float hi) { const h16x2 v = {(_Float16)lo, (_Float16)hi}; return __builtin_bit_cast(unsigned, v); }
__device__ __forceinline__ unsigned pk4_fp8(f32x4 v) { int x = __builtin_amdgcn_cvt_pk_fp8_f32(v[0], v[1], 0, false); x = __builtin_amdgcn_cvt_pk_fp8_f32(v[2], v[3], x, true); return (unsigned)x; }
__device__ __forceinline__ float bf2f(unsigned short h) { return __uint_as_float(((unsigned)h) << 16); }
__device__ __forceinline__ float shfl_xor_l(float v, int o, int lane) { return __int_as_float(__builtin_amdgcn_ds_bpermute((lane ^ o) << 2, __float_as_int(v))); }
__device__ __forceinline__ float wave_sum(float v, int lane) {
#pragma unroll
    for (int o = 1; o < 64; o <<= 1) v += shfl_xor_l(v, o, lane);
    return v;
}
__device__ __forceinline__ f32x2 gelu_pk(f32x2 v) {
    const f32x2 av = __builtin_elementwise_abs(v), d = av * 0.2316418882f + 1.0f;
    f32x2 t; t.x = __builtin_amdgcn_rcpf(d.x); t.y = __builtin_amdgcn_rcpf(d.y);
    f32x2 q = t * 0.5307027145f + (-0.7265760135f); q = q * t + 0.7107068705f; q = q * t + (-0.142248368f); q = q * t + 0.127414796f; q = q * t;
    const f32x2 s = (v * v) * (-0.72134752044f);
    f32x2 e; e.x = __builtin_amdgcn_exp2f(s.x); e.y = __builtin_amdgcn_exp2f(s.y);
    const f32x2 m = v * (q * e), r = v - m;
    f32x2 o; o.x = v.x < 0.f ? m.x : r.x; o.y = v.y < 0.f ? m.y : r.y; return o;
}
__device__ __forceinline__ float silu_f(float g) { return g * __builtin_amdgcn_rcpf(1.0f + __builtin_amdgcn_exp2f(-1.4426950408889634f * g)); }

__device__ __forceinline__ int launder_i(int v) { asm volatile("" : "+v"(v)); return __builtin_amdgcn_readfirstlane(v); }
template <class T> __device__ __forceinline__ T* launder_p(T* p) { unsigned lo = (unsigned)(uintptr_t)p, hi = (unsigned)((uintptr_t)p >> 32); asm volatile("" : "+v"(lo), "+v"(hi));
    lo = __builtin_amdgcn_readfirstlane(lo); hi = __builtin_amdgcn_readfirstlane(hi); return (T*)(((uintptr_t)hi << 32) | (uintptr_t)lo); }

constexpr int WAVE_TBL_OFF = 147456 - 256;
__device__ __forceinline__ int hw_lane() { int l; asm volatile("v_mbcnt_lo_u32_b32 %0, -1, 0\n\tv_mbcnt_hi_u32_b32 %0, -1, %0" : "=v"(l)); return l; }
__device__ __forceinline__ int hw_wave(LAS unsigned char* lds) { const int key = __builtin_amdgcn_s_getreg(0x2804) & 63; const int w = ((volatile LAS int*)(lds + WAVE_TBL_OFF))[key]; return __builtin_amdgcn_readfirstlane(w); }
__device__ __forceinline__ float zero_f() { float z = 0.f; asm volatile("" : "+v"(z)); return z; }
__device__ __forceinline__ void sincos_rev(double rev, float& s, float& c) {
    const double r = rev - rint(rev);
    const double q = rint(4.0 * r);
    const double t = r - 0.25 * q;
    const double a = t * 6.283185307179586476925, a2 = a * a;
    const double sn = a * (1.0 + a2 * (-1.0 / 6 + a2 * (1.0 / 120 + a2 * (-1.0 / 5040 + a2 * (1.0 / 362880 + a2 * (-1.0 / 39916800))))));
    const double cs = 1.0 + a2 * (-0.5 + a2 * (1.0 / 24 + a2 * (-1.0 / 720 + a2 * (1.0 / 40320 + a2 * (-1.0 / 3628800 + a2 * (1.0 / 479001600))))));
    const int qi = ((int)q) & 3;
    double S_, C_;
    if (qi == 0) { S_ = sn; C_ = cs; } else if (qi == 1) { S_ = cs; C_ = -sn; } else if (qi == 2) { S_ = -sn; C_ = -cs; } else { S_ = -cs; C_ = sn; }
    s = (float)S_; c = (float)C_;
}

namespace pg8 {
constexpr int BM = 256, BK = 64, HALF = 128, HTB = HALF * BK * 2, STAGE_BYTES = 8 * HTB, NXCD = 8, WGM = 8;
__device__ __forceinline__ int lds_byte(int r, int c) { const int st = (r >> 4) * 2 + (c >> 5), rr = r & 15, cc = c & 31, ob = rr * 64 + cc * 2; return st * 1024 + (ob ^ (((ob >> 9) & 1) << 5)); }
__device__ __forceinline__ void stage_rc(int b, int& R, int& C) { const int st = b / 1024, sb = b % 1024, swz = sb ^ (((sb >> 9) & 1) << 5); R = (st >> 1) * 16 + swz / 64; C = (st & 1) * 32 + (swz % 64) / 2; }
__device__ __forceinline__ int perm32(int rho) { const int n = rho >> 4, i = rho & 15; return 8 * (i >> 2) + 4 * n + (i & 3); }

struct Unit { int pm, pn; const char* a; const char* b; };
struct Gemm { int lda, ldb; unsigned hstepA, hstepB; int bmul; int K; };

struct StaticOrder {
    int nM, nN, nwg, G, c; const char* A; const char* B; size_t tsA, tsB;
    __device__ void init(int nM_, int nN_, int G_, int c_, const void* A_, size_t tsA_, const void* B_, size_t tsB_) { nM = nM_; nN = nN_; nwg = nM * nN; G = G_; c = c_; A = (const char*)A_; B = (const char*)B_; tsA = tsA_; tsB = tsB_; }
    __device__ bool next(int i, Unit& u) const {
        const long L = (long)i * G + c; if (L >= nwg) return false;
        int wgid = (int)L; { const int q = nwg / NXCD, r = nwg % NXCD, xcd = wgid % NXCD, off = wgid / NXCD; wgid = (xcd < r ? xcd * (q + 1) : r * (q + 1) + (xcd - r) * q) + off; }
        const int nig = WGM * nN, gid = wgid / nig, fm = gid * WGM, gsz = (nM - fm) < WGM ? (nM - fm) : WGM;
        u.pm = fm + ((wgid % nig) % gsz); u.pn = (wgid % nig) / gsz; u.a = launder_p(A + (size_t)u.pm * tsA); u.b = launder_p(B + (size_t)u.pn * tsB); return true;
    }
};
struct SpatialOrder {
    int G, c; const char* A; const char* B; int ldb;
    __device__ bool next(int i, Unit& u) const {
        const int L = i * G + c; if (L >= 1024) return false;
        u.pm = L & 3; u.pn = L >> 2; const int h = u.pn & 1, ch = u.pn >> 1;
        u.a = launder_p(A + (size_t)u.pm * 256 * 128 * 2); u.b = launder_p(B + ((size_t)(512 * u.pm + 128 * h) * ldb + (size_t)ch * 128) * 2); return true;
    }
};

typedef f32x4 Acc[2][2][4][2];

__device__ __forceinline__ u32x4 pack8(f32x4 v0, f32x4 v1) { u32x4 w; w.x = cvt_pk_bf16(v0[0], v0[1]); w.y = cvt_pk_bf16(v0[2], v0[3]); w.z = cvt_pk_bf16(v1[0], v1[1]); w.w = cvt_pk_bf16(v1[2], v1[3]); return w; }

struct EpiF32 { static constexpr bool PERM = false, AFTER_DRAIN = false; float* O; int ldc;
    __device__ __forceinline__ void operator()(const Acc& acc, const Unit& u, int wr, int wc, int fr, int fq) const {
#pragma unroll
        for (int ai = 0; ai < 2; ++ai)
#pragma unroll
            for (int m = 0; m < 4; ++m) { float* rowp = O + (size_t)(u.pm * BM + ai * HALF + wr * 64 + m * 16 + fr) * ldc + u.pn * BM + wc * 32 + 4 * fq;
#pragma unroll
                for (int bj = 0; bj < 2; ++bj)
#pragma unroll
                    for (int n = 0; n < 2; ++n) *(f32x4*)(rowp + bj * HALF + n * 16) = acc[ai][bj][m][n]; }
    }
};
struct EpiF16 { static constexpr bool PERM = true, AFTER_DRAIN = false; _Float16* O; int ldc;
    __device__ __forceinline__ void operator()(const Acc& acc, const Unit& u, int wr, int wc, int fr, int fq) const {
#pragma unroll
        for (int ai = 0; ai < 2; ++ai)
#pragma unroll
            for (int m = 0; m < 4; ++m) { _Float16* rowp = O + (size_t)(u.pm * BM + ai * HALF + wr * 64 + m * 16 + fr) * ldc + u.pn * BM + wc * 32 + 8 * fq;
#pragma unroll
                for (int bj = 0; bj < 2; ++bj) { const h16x4 h0 = __builtin_convertvector(acc[ai][bj][m][0], h16x4), h1 = __builtin_convertvector(acc[ai][bj][m][1], h16x4);
                    *(h16x8*)(rowp + bj * HALF) = __builtin_shufflevector(h0, h1, 0, 1, 2, 3, 4, 5, 6, 7); } }
    }
};
struct EpiResid { static constexpr bool PERM = false, AFTER_DRAIN = false; float* O; int ldc; float alpha;
    __device__ __forceinline__ void operator()(const Acc& acc, const Unit& u, int wr, int wc, int fr, int fq) const {
#pragma unroll
        for (int ai = 0; ai < 2; ++ai)
#pragma unroll
            for (int m = 0; m < 4; ++m) { float* rowp = O + (size_t)(u.pm * BM + ai * HALF + wr * 64 + m * 16 + fr) * ldc + u.pn * BM + wc * 32 + 4 * fq;
#pragma unroll
                for (int bj = 0; bj < 2; ++bj)
#pragma unroll
                    for (int n = 0; n < 2; ++n) { f32x4* p = (f32x4*)(rowp + bj * HALF + n * 16); const f32x4 o = *p; *p = o * alpha + acc[ai][bj][m][n]; } }
    }
};
template <bool SRC_F32> struct EpiResidH { static constexpr bool PERM = false, AFTER_DRAIN = false; _Float16* Ho; const float* Xs; const _Float16* Hs; int ldc; float alpha;
    __device__ __forceinline__ void operator()(const Acc& acc, const Unit& u, int wr, int wc, int fr, int fq) const {
#pragma unroll
        for (int ai = 0; ai < 2; ++ai)
#pragma unroll
            for (int m = 0; m < 4; ++m) { const size_t roff = (size_t)(u.pm * BM + ai * HALF + wr * 64 + m * 16 + fr) * ldc + u.pn * BM + wc * 32 + 4 * fq;
#pragma unroll
                for (int bj = 0; bj < 2; ++bj)
#pragma unroll
                    for (int n = 0; n < 2; ++n) { f32x4 xv; if constexpr (SRC_F32) xv = *(const f32x4*)(Xs + roff + bj * HALF + n * 16); else xv = __builtin_convertvector(*(const h16x4*)(Hs + roff + bj * HALF + n * 16), f32x4);
                        *(h16x4*)(Ho + roff + bj * HALF + n * 16) = __builtin_convertvector(xv * alpha + acc[ai][bj][m][n], h16x4); } }
    }
};
template <int ACT> struct EpiBf16 { static constexpr bool PERM = true, AFTER_DRAIN = false; bf16_t* O; size_t ldc;
    __device__ __forceinline__ void operator()(const Acc& acc, const Unit& u, int wr, int wc, int fr, int fq) const {
#pragma unroll
        for (int ai = 0; ai < 2; ++ai)
#pragma unroll
            for (int m = 0; m < 4; ++m) { bf16_t* rowp = O + (size_t)(u.pm * BM + ai * HALF + wr * 64 + m * 16 + fr) * ldc + u.pn * BM + wc * 32 + 8 * fq;
#pragma unroll
                for (int bj = 0; bj < 2; ++bj) { f32x4 v0 = acc[ai][bj][m][0], v1 = acc[ai][bj][m][1];
                    if (ACT == 1) { f32x2 a = gelu_pk((f32x2){v0[0], v0[1]}), b = gelu_pk((f32x2){v0[2], v0[3]}), c = gelu_pk((f32x2){v1[0], v1[1]}), d = gelu_pk((f32x2){v1[2], v1[3]});
                        v0 = (f32x4){a.x, a.y, b.x, b.y}; v1 = (f32x4){c.x, c.y, d.x, d.y}; }
                    *(u32x4*)(rowp + bj * HALF) = pack8(v0, v1); } }
    }
};
struct EpiGeluColLn { static constexpr bool PERM = true, AFTER_DRAIN = false;
    bf16_t* O; size_t ldc; const float* g; const float* b; unsigned long long* xbuf; unsigned* cnt; LAS unsigned char* sl;
    __device__ __forceinline__ void operator()(Acc& acc, const Unit& u, int wr, int wc, int fr, int fq) const {
        const int lane = fq * 16 + fr, wid = wr * 4 + wc, tid = wid * 64 + lane;
        LAS f32x2* P = (LAS f32x2*)sl; LAS f32x2* Sx = (LAS f32x2*)(sl + 4096);
        f32x4 cs[2][2], cq[2][2];
#pragma unroll
        for (int bj = 0; bj < 2; ++bj)
#pragma unroll
            for (int n = 0; n < 2; ++n) { cs[bj][n] = (f32x4){0.f, 0.f, 0.f, 0.f}; cq[bj][n] = (f32x4){0.f, 0.f, 0.f, 0.f}; }
#pragma unroll
        for (int ai = 0; ai < 2; ++ai)
#pragma unroll
            for (int m = 0; m < 4; ++m)
#pragma unroll
                for (int bj = 0; bj < 2; ++bj)
#pragma unroll
                    for (int n = 0; n < 2; ++n) { const f32x4 v = acc[ai][bj][m][n]; const f32x2 a = gelu_pk((f32x2){v[0], v[1]}), c = gelu_pk((f32x2){v[2], v[3]});
                        const f32x4 gv = {a.x, a.y, c.x, c.y}; acc[ai][bj][m][n] = gv; cs[bj][n] += gv; cq[bj][n] += gv * gv; }
#pragma unroll
        for (int bj = 0; bj < 2; ++bj)
#pragma unroll
            for (int n = 0; n < 2; ++n)
#pragma unroll
                for (int j = 0; j < 4; ++j) { float s = cs[bj][n][j], q = cq[bj][n][j];
#pragma unroll
                    for (int o = 1; o < 16; o <<= 1) { s += shfl_xor_l(s, o, lane); q += shfl_xor_l(q, o, lane); }
                    if (fr == 0) P[wr * 256 + bj * HALF + wc * 32 + 8 * fq + 4 * n + j] = (f32x2){s, q}; }
        asm volatile("s_waitcnt lgkmcnt(0)" ::: "memory"); __builtin_amdgcn_s_barrier(); asm volatile("" ::: "memory");
        if (tid < 256) { const f32x2 a = P[tid], c = P[256 + tid];
            __hip_atomic_store(xbuf + ((size_t)u.pn * 256 + tid) * 8 + u.pm, ((unsigned long long)__float_as_uint(a.y + c.y) << 32) | __float_as_uint(a.x + c.x), __ATOMIC_RELAXED, __HIP_MEMORY_SCOPE_AGENT); }
        asm volatile("s_waitcnt vmcnt(0)" ::: "memory");
        if (lane == 0) __hip_atomic_fetch_add(cnt + 64 * u.pn, 1u, __ATOMIC_RELAXED, __HIP_MEMORY_SCOPE_AGENT);
        if (wid == 0) { unsigned sp = 0;
            while ((unsigned)__builtin_amdgcn_readfirstlane(__hip_atomic_load(cnt + 64 * u.pn, __ATOMIC_RELAXED, __HIP_MEMORY_SCOPE_AGENT)) < 64u) { __builtin_amdgcn_s_sleep(2); if (++sp > (1u << 22)) break; }
            __builtin_amdgcn_fence(__ATOMIC_ACQUIRE, "agent"); }
        asm volatile("s_waitcnt vmcnt(0) lgkmcnt(0)" ::: "memory"); __builtin_amdgcn_s_barrier(); asm volatile("" ::: "memory");
        if (tid < 256) { const unsigned long long* slot = xbuf + ((size_t)u.pn * 256 + tid) * 8; float ts = 0.f, tq = 0.f;
#pragma unroll
            for (int t = 0; t < 8; ++t) { const unsigned long long w = __hip_atomic_load(slot + t, __ATOMIC_RELAXED, __HIP_MEMORY_SCOPE_AGENT); ts += __uint_as_float((unsigned)w); tq += __uint_as_float((unsigned)(w >> 32)); }
            const float mean = ts * (1.f / 2048.f); const float var = fmaxf(tq * (1.f / 2048.f) - mean * mean, 0.f); Sx[tid] = (f32x2){mean, 1.f / sqrtf(var + LN_EPS)}; }
        asm volatile("s_waitcnt lgkmcnt(0)" ::: "memory"); __builtin_amdgcn_s_barrier(); asm volatile("" ::: "memory");
#pragma unroll
        for (int bj = 0; bj < 2; ++bj) { f32x4 mu[2], rs[2];
#pragma unroll
            for (int n = 0; n < 2; ++n)
#pragma unroll
                for (int j = 0; j < 4; ++j) { const f32x2 s = Sx[bj * HALF + wc * 32 + 8 * fq + 4 * n + j]; mu[n][j] = s.x; rs[n][j] = s.y; }
#pragma unroll
            for (int ai = 0; ai < 2; ++ai)
#pragma unroll
                for (int m = 0; m < 4; ++m) { const int ch = u.pm * BM + ai * HALF + wr * 64 + m * 16 + fr; const float gg = g[ch], bb = b[ch];
                    const f32x4 v0 = (acc[ai][bj][m][0] - mu[0]) * rs[0] * gg + bb, v1 = (acc[ai][bj][m][1] - mu[1]) * rs[1] * gg + bb;
                    *(u32x4*)(O + (size_t)ch * ldc + u.pn * BM + bj * HALF + wc * 32 + 8 * fq) = pack8(v0, v1); } }
        asm volatile("s_waitcnt lgkmcnt(0)" ::: "memory"); __builtin_amdgcn_s_barrier(); asm volatile("" ::: "memory");
    }
};
struct EpiSwiglu { static constexpr bool PERM = true, AFTER_DRAIN = false; bf16_t* O; int ldc;
    __device__ __forceinline__ void operator()(const Acc& acc, const Unit& u, int wr, int wc, int fr, int fq) const {
#pragma unroll
        for (int ai = 0; ai < 2; ++ai)
#pragma unroll
            for (int m = 0; m < 4; ++m) { bf16_t* rowp = O + (size_t)(u.pm * BM + ai * HALF + wr * 64 + m * 16 + fr) * ldc + u.pn * HALF + wc * 32 + 8 * fq;
                f32x4 v0, v1;
#pragma unroll
                for (int j = 0; j < 4; ++j) { v0[j] = silu_f(acc[ai][0][m][0][j]) * acc[ai][1][m][0][j]; v1[j] = silu_f(acc[ai][0][m][1][j]) * acc[ai][1][m][1][j]; }
                *(u32x4*)rowp = pack8(v0, v1); }
    }
};
constexpr float QSC = 0.07216878364870323f * 1.4426950408889634f;
struct EpiQ { static constexpr bool PERM = true, AFTER_DRAIN = false; unsigned char* Q; const float* rc; const float* rs;
    __device__ __forceinline__ void operator()(const Acc& acc, const Unit& u, int wr, int wc, int fr, int fq) const {
#pragma unroll
        for (int ai = 0; ai < 2; ++ai)
#pragma unroll
            for (int m = 0; m < 4; ++m) { const int row = u.pm * BM + ai * HALF + wr * 64 + m * 16 + fr;
                if (u.pn < 4) {
#pragma unroll
                    for (int bj = 0; bj < 2; ++bj) { const int head = 2 * u.pn + bj;
                        *(u32x2*)(Q + ((size_t)head * S + row) * 192 + wc * 32 + 8 * fq) = (u32x2){pk4_fp8(acc[ai][bj][m][0] * QSC), pk4_fp8(acc[ai][bj][m][1] * QSC)}; }
                } else { const int head = 4 * (u.pn - 4) + wc; const int d0 = 8 * fq;
                    const f32x4 c0 = *(const f32x4*)(rc + (size_t)row * 32 + d0), c1 = *(const f32x4*)(rc + (size_t)row * 32 + d0 + 4);
                    const f32x4 s0 = *(const f32x4*)(rs + (size_t)row * 32 + d0), s1 = *(const f32x4*)(rs + (size_t)row * 32 + d0 + 4);
                    const f32x4 a0 = acc[ai][0][m][0] * QSC, a1 = acc[ai][0][m][1] * QSC, b0 = acc[ai][1][m][0] * QSC, b1 = acc[ai][1][m][1] * QSC;
                    unsigned char* qp = Q + ((size_t)head * S + row) * 192 + 128 + d0;
                    *(u32x2*)qp = (u32x2){pk4_fp8(a0 * c0 - b0 * s0), pk4_fp8(a1 * c1 - b1 * s1)};
                    *(u32x2*)(qp + 32) = (u32x2){pk4_fp8(a0 * s0 + b0 * c0), pk4_fp8(a1 * s1 + b1 * c1)}; }
            }
    }
};
struct EpiFp8 { static constexpr bool PERM = true, AFTER_DRAIN = false; unsigned char* O; size_t ldc;
    __device__ __forceinline__ void operator()(const Acc& acc, const Unit& u, int wr, int wc, int fr, int fq) const {
#pragma unroll
        for (int ai = 0; ai < 2; ++ai)
#pragma unroll
            for (int m = 0; m < 4; ++m) { unsigned char* rowp = O + (size_t)(u.pm * BM + ai * HALF + wr * 64 + m * 16 + fr) * ldc + u.pn * BM + wc * 32 + 8 * fq;
#pragma unroll
                for (int bj = 0; bj < 2; ++bj) *(u32x2*)(rowp + bj * HALF) = (u32x2){pk4_fp8(acc[ai][bj][m][0]), pk4_fp8(acc[ai][bj][m][1])}; }
    }
};
struct EpiF1 { static constexpr bool PERM = true, AFTER_DRAIN = false; bf16_t* AP; const f32x2* tw;
    __device__ __forceinline__ void operator()(const Acc& acc, const Unit& u, int wr, int wc, int fr, int fq) const {
        const int g = u.pn >> 7, ch = u.pn & 127, b0 = wc * 32 + 8 * fq;
#pragma unroll
        for (int m = 0; m < 4; ++m) { const int ka = wr * 64 + m * 16 + fr;
            f32x4 orr[2], oi[2];
#pragma unroll
            for (int n = 0; n < 2; ++n) { const f32x4 c1r = acc[0][0][m][n] - acc[1][1][m][n], c1i = -(acc[0][1][m][n] + acc[1][0][m][n]);
#pragma unroll
                for (int j = 0; j < 4; ++j) { const f32x2 t = tw[ka * 128 + b0 + 4 * n + j];
                    orr[n][j] = c1r[j] * t.x + c1i[j] * t.y; oi[n][j] = c1i[j] * t.x - c1r[j] * t.y; } }
            bf16_t* p = AP + ((((size_t)ka * 4 + g) * 2) * 128 + ch) * 128 + b0;
            *(u32x4*)p = pack8(orr[0], orr[1]); *(u32x4*)(p + 128 * 128) = pack8(oi[0], oi[1]); }
    }
};
struct EpiF2 { static constexpr bool PERM = true, AFTER_DRAIN = false; bf16_t* MF;
    __device__ __forceinline__ void operator()(const Acc& acc, const Unit& u, int wr, int wc, int fr, int fq) const {
        const int ka = u.pn >> 2, g = u.pn & 3;
#pragma unroll
        for (int m = 0; m < 4; ++m) { const int kb = wr * 64 + m * 16 + fr;
            *(u32x4*)(MF + (size_t)(ka + 128 * kb) * 1536 + 1024 + g * 128 + wc * 32 + 8 * fq) = pack8(acc[0][0][m][0] + acc[1][1][m][0], acc[0][0][m][1] + acc[1][1][m][1]); }
    }
};
struct EpiSpatial { static constexpr bool PERM = true, AFTER_DRAIN = false; bf16_t* U; const float* bs;
    __device__ __forceinline__ void operator()(const Acc& acc, const Unit& u, int wr, int wc, int fr, int fq) const {
        const int h = u.pn & 1, chunk = u.pn >> 1;
#pragma unroll
        for (int t = 0; t < 2; ++t) { const int g = 2 * u.pm + t;
#pragma unroll
            for (int m = 0; m < 4; ++m) { const int p = wr * 64 + m * 16 + fr; const float b = bs[g * 128 + p];
                bf16_t* up = U + (size_t)(chunk * 128 + p) * 2048 + g * 256 + h * 128 + wc * 32 + 8 * fq;
                const u32x4 uv = *(const u32x4*)up; f32x4 v0, v1;
                v0[0] = __uint_as_float(uv.x << 16); v0[1] = __uint_as_float(uv.x & 0xffff0000u); v0[2] = __uint_as_float(uv.y << 16); v0[3] = __uint_as_float(uv.y & 0xffff0000u);
                v1[0] = __uint_as_float(uv.z << 16); v1[1] = __uint_as_float(uv.z & 0xffff0000u); v1[2] = __uint_as_float(uv.w << 16); v1[3] = __uint_as_float(uv.w & 0xffff0000u);
                *(u32x4*)up = pack8(v0 * (acc[t][t][m][0] + b), v1 * (acc[t][t][m][1] + b)); } }
    }
};


template <bool WRITE_F32, bool WRITE_F16, bool SRC_F32 = false> struct EpiLn { static constexpr bool PERM = true, AFTER_DRAIN = true;
    const _Float16* Hs; _Float16* Ho; float* X; const float* Xs; const float* g; const float* b; float alpha; unsigned long long* xbuf; unsigned* cnt;
    __device__ __forceinline__ void fused(Acc& acc, const Unit& u, int wr, int wc, int fr, int fq, LAS unsigned char* lds, int wid, int lane) const {
        const int col0 = u.pn * BM + wc * 32 + 8 * fq;
#pragma unroll
        for (int ai = 0; ai < 2; ++ai)
#pragma unroll
            for (int m = 0; m < 4; ++m) { const size_t roff = (size_t)(u.pm * BM + ai * HALF + wr * 64 + m * 16 + fr) * DM + col0;
#pragma unroll
                for (int bj = 0; bj < 2; ++bj) {
                    if constexpr (SRC_F32) { acc[ai][bj][m][0] += *(const f32x4*)(Xs + roff + bj * HALF) * alpha; acc[ai][bj][m][1] += *(const f32x4*)(Xs + roff + bj * HALF + 4) * alpha; }
                    else { const h16x8 hv = *(const h16x8*)(Hs + roff + bj * HALF);
                        acc[ai][bj][m][0] += __builtin_convertvector(__builtin_shufflevector(hv, hv, 0, 1, 2, 3), f32x4) * alpha;
                        acc[ai][bj][m][1] += __builtin_convertvector(__builtin_shufflevector(hv, hv, 4, 5, 6, 7), f32x4) * alpha; } }
                asm volatile("" ::: "memory"); }
        LAS f32x2* P = (LAS f32x2*)lds; LAS f32x2* Sx = (LAS f32x2*)(lds + 8192);
#pragma unroll
        for (int ai = 0; ai < 2; ++ai)
#pragma unroll
            for (int m = 0; m < 4; ++m) { float s = 0.f;
#pragma unroll
                for (int bj = 0; bj < 2; ++bj)
#pragma unroll
                    for (int n = 0; n < 2; ++n) { const f32x4 x = acc[ai][bj][m][n]; s += (x[0] + x[1]) + (x[2] + x[3]); }
                s += shfl_xor_l(s, 16, lane); s += shfl_xor_l(s, 32, lane);
                const float mw = s * (1.0f / 64.0f); float q = 0.f;
#pragma unroll
                for (int bj = 0; bj < 2; ++bj)
#pragma unroll
                    for (int n = 0; n < 2; ++n) { const f32x4 d = acc[ai][bj][m][n] - mw; q += (d[0] * d[0] + d[1] * d[1]) + (d[2] * d[2] + d[3] * d[3]); }
                q += shfl_xor_l(q, 16, lane); q += shfl_xor_l(q, 32, lane);
                if (fq == 0) P[(ai * HALF + wr * 64 + m * 16 + fr) * 4 + wc] = (f32x2){mw, q}; }
        asm volatile("s_waitcnt lgkmcnt(0)" ::: "memory"); __builtin_amdgcn_s_barrier(); asm volatile("" ::: "memory");
        const int row = wid * 32 + (lane & 31);
        if (lane < 32) { const f32x2 a = P[row * 4 + 0], b2 = P[row * 4 + 1], c = P[row * 4 + 2], d = P[row * 4 + 3];
            const float mt = (a.x + b2.x + c.x + d.x) * 0.25f; const float da = a.x - mt, db = b2.x - mt, dc = c.x - mt, dd = d.x - mt;
            const float m2 = (a.y + b2.y) + (c.y + d.y) + 64.0f * ((da * da + db * db) + (dc * dc + dd * dd));
            __hip_atomic_store(xbuf + ((size_t)(u.pm * BM + row) * 4 + u.pn), ((unsigned long long)__float_as_uint(m2) << 32) | __float_as_uint(mt), __ATOMIC_RELAXED, __HIP_MEMORY_SCOPE_AGENT); }
        asm volatile("s_waitcnt vmcnt(0)" ::: "memory");
        if (lane == 0) __hip_atomic_fetch_add(cnt + 64 * u.pm, 1u, __ATOMIC_RELAXED, __HIP_MEMORY_SCOPE_AGENT);
        if (wid == 0) { unsigned sp = 0;
            while ((unsigned)__builtin_amdgcn_readfirstlane(__hip_atomic_load(cnt + 64 * u.pm, __ATOMIC_RELAXED, __HIP_MEMORY_SCOPE_AGENT)) < 32u) { __builtin_amdgcn_s_sleep(2); if (++sp > (1u << 22)) break; }
            __builtin_amdgcn_fence(__ATOMIC_ACQUIRE, "agent"); }
        asm volatile("s_waitcnt vmcnt(0) lgkmcnt(0)" ::: "memory"); __builtin_amdgcn_s_barrier(); asm volatile("" ::: "memory");
        if (lane < 32) { const unsigned long long* slot = xbuf + (size_t)(u.pm * BM + row) * 4; float mt[4], m2[4]; float ms = 0.f;
#pragma unroll
            for (int t = 0; t < 4; ++t) { const unsigned long long w = __hip_atomic_load(slot + t, __ATOMIC_RELAXED, __HIP_MEMORY_SCOPE_AGENT); mt[t] = __uint_as_float((unsigned)w); m2[t] = __uint_as_float((unsigned)(w >> 32)); ms += mt[t]; }
            const float mean = ms * 0.25f; float q = 0.f;
#pragma unroll
            for (int t = 0; t < 4; ++t) { const float dm = mt[t] - mean; q += m2[t] + 256.0f * dm * dm; }
            Sx[row] = (f32x2){mean, 1.0f / sqrtf(q * (1.0f / 1024.0f) + LN_EPS)}; }
        asm volatile("s_waitcnt lgkmcnt(0)" ::: "memory"); __builtin_amdgcn_s_barrier(); asm volatile("" ::: "memory");
        int fr6 = fr, fq6 = fq; asm volatile("" : "+v"(fr6), "+v"(fq6));
        const int col6 = u.pn * BM + wc * 32 + 8 * fq6;
#pragma unroll
        for (int bj = 0; bj < 2; ++bj) { const f32x4 gv0 = *(const f32x4*)(g + col6 + bj * HALF), gv1 = *(const f32x4*)(g + col6 + bj * HALF + 4), bv0 = *(const f32x4*)(b + col6 + bj * HALF), bv1 = *(const f32x4*)(b + col6 + bj * HALF + 4);
#pragma unroll
            for (int ai = 0; ai < 2; ++ai)
#pragma unroll
                for (int m = 0; m < 4; ++m) { const int r = ai * HALF + wr * 64 + m * 16 + fr6; const f32x2 sr = Sx[r]; const size_t off = (size_t)(u.pm * BM + r) * DM + col6 + bj * HALF;
                    const f32x4 o0 = (acc[ai][bj][m][0] - sr.x) * sr.y * gv0 + bv0, o1 = (acc[ai][bj][m][1] - sr.x) * sr.y * gv1 + bv1;
                    if constexpr (WRITE_F32) { *(f32x4*)(X + off) = o0; *(f32x4*)(X + off + 4) = o1; }
                    if constexpr (WRITE_F16) { const h16x4 h0 = __builtin_convertvector(o0, h16x4), h1 = __builtin_convertvector(o1, h16x4); *(h16x8*)(Ho + off) = __builtin_shufflevector(h0, h1, 0, 1, 2, 3, 4, 5, 6, 7); } }
            asm volatile("" ::: "memory"); }
    }
};

template <bool F16 = false, class Epi, class Sched>
__device__ __forceinline__ void gemm_phase(LAS unsigned char* lds, const Gemm g, const Sched& Sc, const Epi& E, int tid) {
    const int wid = __builtin_amdgcn_readfirstlane(tid >> 6), lane = tid & 63, wr = wid >> 2, wc = wid & 3, fr = lane & 15, fq = lane >> 4;
    const int nt = launder_i(g.K / BK);
    unsigned voffA[2], voffB[2];
#pragma unroll
    for (int i = 0; i < 2; ++i) { int R, C; stage_rc(tid * 16 + i * 8192, R, C); const int Rb = Epi::PERM ? ((R & ~31) + perm32(R & 31)) : R;
        voffA[i] = (unsigned)(R * g.lda + C) * 2u; voffB[i] = (unsigned)(Rb * g.bmul * g.ldb + C) * 2u; }
    const size_t kstep = (size_t)(BK * 2);
    const size_t hsA = g.hstepA, hsB = g.hstepB;
    const unsigned ldsw = (unsigned)wid * 1024u;
    const int aoff = lds_byte(wr * 64 + fr, fq * 8), boff = lds_byte(wc * 32 + fr, fq * 8);
#define PG8_SA(b, h) (((b) * 2 + (h)) * HTB)
#define PG8_SB(b, h) ((4 + (b) * 2 + (h)) * HTB)
#define PG8_STAGE(bufoff, gbase, voff) do { _Pragma("unroll") for (int _i = 0; _i < 2; ++_i) \
        __builtin_amdgcn_global_load_lds((const unsigned*)((const char*)(gbase) + (voff)[_i]), (LAS unsigned*)(lds + (bufoff) + ldsw + _i * 8192), 16, 0, 0); } while (0)
#define PG8_LDA(dst, b, h) do { _Pragma("unroll") for (int m = 0; m < 4; ++m) _Pragma("unroll") for (int k = 0; k < 2; ++k) dst[m][k] = *(const LAS bf16x8*)(lds + PG8_SA(b, h) + aoff + m * 2048 + k * 1024); } while (0)
#define PG8_LDB(dst, b, h) do { _Pragma("unroll") for (int n = 0; n < 2; ++n) _Pragma("unroll") for (int k = 0; k < 2; ++k) dst[n][k] = *(const LAS bf16x8*)(lds + PG8_SB(b, h) + boff + n * 2048 + k * 1024); } while (0)
#define PG8_MMA(ai, bj, At, Bt) do { __builtin_amdgcn_s_setprio(1); _Pragma("unroll") for (int m = 0; m < 4; ++m) _Pragma("unroll") for (int n = 0; n < 2; ++n) _Pragma("unroll") for (int k = 0; k < 2; ++k) \
        { if constexpr (F16) acc[ai][bj][m][n] = __builtin_amdgcn_mfma_f32_16x16x32_f16(__builtin_bit_cast(h16x8, Bt[n][k]), __builtin_bit_cast(h16x8, At[m][k]), acc[ai][bj][m][n], 0, 0, 0); \
          else acc[ai][bj][m][n] = __builtin_amdgcn_mfma_f32_16x16x32_bf16(Bt[n][k], At[m][k], acc[ai][bj][m][n], 0, 0, 0); } __builtin_amdgcn_s_setprio(0); } while (0)
#define PG8_WAIT_V(n) asm volatile("s_waitcnt vmcnt(" #n ")" ::: "memory")
#define PG8_WAIT_L(n) asm volatile("s_waitcnt lgkmcnt(" #n ")" ::: "memory")
#define PG8_BAR __builtin_amdgcn_s_barrier()
#define PG8_SCHED __builtin_amdgcn_sched_barrier(0)
    Unit cur, nxt; int ui = 0;
    if (!Sc.next(0, cur)) return;
    Acc acc;
#pragma unroll
    for (int a = 0; a < 2; ++a)
#pragma unroll
        for (int b = 0; b < 2; ++b)
#pragma unroll
            for (int m = 0; m < 4; ++m)
#pragma unroll
                for (int n = 0; n < 2; ++n) { const float z = zero_f(); acc[a][b][m][n] = (f32x4){z, z, z, z}; }
    bf16x8 At[4][2], B0[2][2], B1[2][2];
    const char* cA = cur.a; const char* cB = cur.b;
    PG8_STAGE(PG8_SB(0, 0), cB, voffB); PG8_STAGE(PG8_SB(0, 1), cB + hsB, voffB); PG8_STAGE(PG8_SA(0, 0), cA, voffA); PG8_STAGE(PG8_SA(0, 1), cA + hsA, voffA);
    if (wr == 1) PG8_BAR;
    PG8_WAIT_V(2); PG8_BAR;
    PG8_STAGE(PG8_SB(1, 0), cB + kstep, voffB); PG8_STAGE(PG8_SA(1, 0), cA + kstep, voffA); PG8_STAGE(PG8_SB(1, 1), cB + hsB + kstep, voffB);
    PG8_WAIT_V(6); PG8_BAR;
    for (;;) {
        const bool has_next = Sc.next(ui + 1, nxt);
        const char* nA = has_next ? nxt.a : cA; const char* nB = has_next ? nxt.b : cB;
#pragma nounroll
        for (int t = 0; t < nt; t += 2) {
            const bool last = (t == nt - 2);
            const char* a1 = cA + (size_t)(t + 1) * kstep;
            const char* a2 = last ? nA : cA + (size_t)(t + 2) * kstep; const char* b2 = last ? nB : cB + (size_t)(t + 2) * kstep;
            const char* a3 = a2 + kstep; const char* b3 = b2 + kstep;
            PG8_LDB(B0, 0, 0); PG8_LDB(B1, 0, 1); PG8_SCHED; PG8_LDA(At, 0, 0); PG8_STAGE(PG8_SA(1, 1), a1 + hsA, voffA);
            PG8_WAIT_V(8); PG8_WAIT_L(0); PG8_BAR; PG8_MMA(0, 0, At, B0); PG8_MMA(0, 1, At, B1); PG8_BAR; PG8_SCHED;
            PG8_LDA(At, 0, 1); PG8_STAGE(PG8_SB(0, 0), b2, voffB); PG8_STAGE(PG8_SB(0, 1), b2 + hsB, voffB); PG8_STAGE(PG8_SA(0, 0), a2, voffA);
            PG8_WAIT_V(8); PG8_WAIT_L(0); PG8_BAR; PG8_MMA(1, 0, At, B0); PG8_MMA(1, 1, At, B1); PG8_BAR; PG8_SCHED;
            PG8_LDB(B0, 1, 0); PG8_LDB(B1, 1, 1); PG8_SCHED; PG8_LDA(At, 1, 0); PG8_STAGE(PG8_SA(0, 1), a2 + hsA, voffA);
            PG8_WAIT_V(8); PG8_WAIT_L(0); PG8_BAR; PG8_MMA(0, 0, At, B0); PG8_MMA(0, 1, At, B1); PG8_BAR; PG8_SCHED;
            PG8_LDA(At, 1, 1); PG8_STAGE(PG8_SB(1, 0), b3, voffB); PG8_STAGE(PG8_SB(1, 1), b3 + hsB, voffB); PG8_STAGE(PG8_SA(1, 0), a3, voffA);
            PG8_WAIT_V(8); PG8_WAIT_L(0); PG8_BAR; PG8_MMA(1, 0, At, B0); PG8_MMA(1, 1, At, B1); PG8_BAR; PG8_SCHED;
        }
        if (wr == 0) PG8_BAR;
        if constexpr (!Epi::AFTER_DRAIN) { int fr2 = fr, fq2 = fq; asm volatile("" : "+v"(fr2), "+v"(fq2)); E(acc, cur, wr, wc, fr2, fq2); }
        if (!has_next) break;
#pragma unroll
        for (int a = 0; a < 2; ++a)
#pragma unroll
            for (int b = 0; b < 2; ++b)
#pragma unroll
                for (int m = 0; m < 4; ++m)
#pragma unroll
                    for (int n = 0; n < 2; ++n) { const float z = zero_f(); acc[a][b][m][n] = (f32x4){z, z, z, z}; }
        cur = nxt; cA = nA; cB = nB; ++ui;
        if (wr == 1) PG8_BAR;
    }
    PG8_WAIT_V(0);
    PG8_BAR;
    if constexpr (Epi::AFTER_DRAIN) { int fr2 = fr, fq2 = fq, ln2 = lane; asm volatile("" : "+v"(fr2), "+v"(fq2), "+v"(ln2)); E.fused(acc, cur, wr, wc, fr2, fq2, lds, wid, ln2); }
#undef PG8_SA
#undef PG8_SB
#undef PG8_STAGE
#undef PG8_LDA
#undef PG8_LDB
#undef PG8_MMA
#undef PG8_WAIT_V
#undef PG8_WAIT_L
#undef PG8_BAR
#undef PG8_SCHED
}
}

namespace att {
constexpr int KVBLK = 64, SHM_V = 64 * 128 * 2, SHM_K = 64 * 400;
constexpr int LDS_V = 0, LDS_K = 3 * SHM_V, LDS_WS = 3 * SHM_V + 2 * SHM_K, LDS_QR = LDS_WS + NW * 64 * 4, LDS_BYTES = LDS_QR + NW * 32 * 144;
static_assert(LDS_BYTES <= 146944, "attention LDS");
constexpr float SCALE = 0.07216878364870323f;
constexpr float THR = 8.f;
#define KSWZ(row, colB) ((row) * 400 + (colB))
#define SBAR() __builtin_amdgcn_sched_barrier(0)
__device__ __forceinline__ int crow(int r, int hi) { return (r & 3) + 8 * (r >> 2) + 4 * hi; }
__device__ __forceinline__ int v_st(int k, int c) { const int kk = (k & ~0xC) | ((k & 4) << 1) | ((k & 8) >> 1); return ((kk >> 3) * 4 + (c >> 5)) * 512 + ((kk & 7) * 32 + (c & 31)) * 2; }
__device__ __forceinline__ int v_rd_base(int lane) { return ((lane & 3) << 3) | (((lane >> 2) & 3) << 6) | (((lane >> 4) & 1) << 5) | (((lane >> 5) & 1) << 8); }
constexpr int v_rd_off(int d0, int ks, int half) { return d0 * 512 + ks * 4096 + half * 2048; }
template <int OFF> __device__ __forceinline__ s16x4 tr_read(int vb) { s16x4 r; asm volatile("ds_read_b64_tr_b16 %0, %1 offset:%2" : "=&v"(r) : "v"(vb), "i"(OFF) : "memory"); return r; }
template <int D0> __device__ __forceinline__ void pv_one(f32x16& od, int vb, bf16x8 pa0, bf16x8 pa1, bf16x8 pa2, bf16x8 pa3) {
    const s16x4 l0 = tr_read<v_rd_off(D0, 0, 0)>(vb), h0 = tr_read<v_rd_off(D0, 0, 1)>(vb), l1 = tr_read<v_rd_off(D0, 1, 0)>(vb), h1 = tr_read<v_rd_off(D0, 1, 1)>(vb);
    const s16x4 l2 = tr_read<v_rd_off(D0, 2, 0)>(vb), h2 = tr_read<v_rd_off(D0, 2, 1)>(vb), l3 = tr_read<v_rd_off(D0, 3, 0)>(vb), h3 = tr_read<v_rd_off(D0, 3, 1)>(vb);
    asm volatile("s_waitcnt lgkmcnt(0)" ::: "memory"); SBAR();
#define PK(L, H) (bf16x8){L[0], L[1], L[2], L[3], H[0], H[1], H[2], H[3]}
    od = __builtin_amdgcn_mfma_f32_32x32x16_bf16(pa0, PK(l0, h0), od, 0, 0, 0);
    od = __builtin_amdgcn_mfma_f32_32x32x16_bf16(pa1, PK(l1, h1), od, 0, 0, 0);
    od = __builtin_amdgcn_mfma_f32_32x32x16_bf16(pa2, PK(l2, h2), od, 0, 0, 0);
    od = __builtin_amdgcn_mfma_f32_32x32x16_bf16(pa3, PK(l3, h3), od, 0, 0, 0);
#undef PK
}
__device__ __forceinline__ void qkt(f32x16& p0, f32x16& p1, const char* Ks, const bf16x8* qr, const char* qrl, int r32, int hi) {
    p0 = f32x16{}; p1 = f32x16{};
#pragma unroll
    for (int d0 = 0; d0 < 12; ++d0) { const int cb = (d0 * 16 + hi * 8) * 2;
        const bf16x8 b0 = *reinterpret_cast<const bf16x8*>(Ks + KSWZ(r32, cb));
        const bf16x8 b1 = *reinterpret_cast<const bf16x8*>(Ks + KSWZ(32 + r32, cb));
        const bf16x8 q = (d0 < 8) ? qr[d0 < 8 ? d0 : 0] : *reinterpret_cast<const bf16x8*>(qrl + (d0 - 8) * 32);
        p0 = __builtin_amdgcn_mfma_f32_32x32x16_bf16(b0, q, p0, 0, 0, 0);
        p1 = __builtin_amdgcn_mfma_f32_32x32x16_bf16(b1, q, p1, 0, 0, 0); }
}
__device__ __forceinline__ void partialSM(f32x16& p0, f32x16& p1, float& m_reg, float& mn, float& alpha) {
    constexpr float C = SCALE * 1.4426950408889634f;
    float pmax = p0[0];
#pragma unroll
    for (int r = 1; r < 16; ++r) pmax = fmaxf(pmax, p0[r]);
#pragma unroll
    for (int r = 0; r < 16; ++r) pmax = fmaxf(pmax, p1[r]);
    { auto rr = __builtin_amdgcn_permlane32_swap(__float_as_uint(pmax), __float_as_uint(pmax), false, false); pmax = fmaxf(__uint_as_float(rr[0]), __uint_as_float(rr[1])); }
    if (__builtin_expect(__all(pmax - m_reg <= THR / SCALE), 1)) { mn = m_reg; alpha = 1.f; }
    else { mn = fmaxf(m_reg, pmax); alpha = __builtin_amdgcn_exp2f((m_reg - mn) * C); m_reg = mn; }
    const float mnC = -mn * C;
#pragma unroll
    for (int r = 0; r < 16; ++r) p0[r] = fmaf(p0[r], C, mnC);
#pragma unroll
    for (int r = 0; r < 16; ++r) p1[r] = fmaf(p1[r], C, mnC);
#pragma unroll
    for (int r = 0; r < 16; ++r) p0[r] = __builtin_amdgcn_exp2f(p0[r]);
}
__device__ __forceinline__ void finishSM(f32x16& p0, f32x16& p1, float alpha, float& l_reg, bf16x8& pa0, bf16x8& pa1, bf16x8& pa2, bf16x8& pa3) {
#pragma unroll
    for (int r = 0; r < 16; ++r) p1[r] = __builtin_amdgcn_exp2f(p1[r]);
    float ps = 0.f;
#pragma unroll
    for (int r = 0; r < 16; ++r) ps += p0[r];
#pragma unroll
    for (int r = 0; r < 16; ++r) ps += p1[r];
    { auto rr = __builtin_amdgcn_permlane32_swap(__float_as_uint(ps), __float_as_uint(ps), false, false); ps = __uint_as_float(rr[0]) + __uint_as_float(rr[1]); }
    l_reg = l_reg * alpha + ps;
#define PK4(P, BASE, OUT) do { unsigned a0 = cvt_pk_bf16(P[BASE + 0], P[BASE + 1]), a1 = cvt_pk_bf16(P[BASE + 2], P[BASE + 3]);   \
    unsigned b0 = cvt_pk_bf16(P[BASE + 4], P[BASE + 5]), b1 = cvt_pk_bf16(P[BASE + 6], P[BASE + 7]);                              \
    auto r0 = __builtin_amdgcn_permlane32_swap(a0, b0, false, false); auto r1 = __builtin_amdgcn_permlane32_swap(a1, b1, false, false); \
    u32x4 w = {r0[0], r1[0], r0[1], r1[1]}; OUT = *reinterpret_cast<bf16x8*>(&w); } while (0)
    PK4(p0, 0, pa0); PK4(p0, 8, pa1); PK4(p1, 0, pa2); PK4(p1, 8, pa3);
#undef PK4
}
template <int D0> __device__ __forceinline__ void v_rd8(s16x4* f, int vb) {
    f[0] = tr_read<v_rd_off(D0, 0, 0)>(vb); f[1] = tr_read<v_rd_off(D0, 0, 1)>(vb); f[2] = tr_read<v_rd_off(D0, 1, 0)>(vb); f[3] = tr_read<v_rd_off(D0, 1, 1)>(vb);
    f[4] = tr_read<v_rd_off(D0, 2, 0)>(vb); f[5] = tr_read<v_rd_off(D0, 2, 1)>(vb); f[6] = tr_read<v_rd_off(D0, 3, 0)>(vb); f[7] = tr_read<v_rd_off(D0, 3, 1)>(vb);
}
__device__ __forceinline__ void pv_mma(f32x16& od, const s16x4* f, bf16x8 pa0, bf16x8 pa1, bf16x8 pa2, bf16x8 pa3) {
#define PK(L, H) (bf16x8){L[0], L[1], L[2], L[3], H[0], H[1], H[2], H[3]}
    od = __builtin_amdgcn_mfma_f32_32x32x16_bf16(pa0, PK(f[0], f[1]), od, 0, 0, 0);
    od = __builtin_amdgcn_mfma_f32_32x32x16_bf16(pa1, PK(f[2], f[3]), od, 0, 0, 0);
    od = __builtin_amdgcn_mfma_f32_32x32x16_bf16(pa2, PK(f[4], f[5]), od, 0, 0, 0);
    od = __builtin_amdgcn_mfma_f32_32x32x16_bf16(pa3, PK(f[6], f[7]), od, 0, 0, 0);
#undef PK
}
__device__ __forceinline__ void pv_d0(f32x16* o, int vb, bf16x8 pa0, bf16x8 pa1, bf16x8 pa2, bf16x8 pa3) {
    s16x4 fa[8], fb[8];
    __builtin_amdgcn_s_setprio(1);
    v_rd8<0>(fa, vb); v_rd8<1>(fb, vb);
    asm volatile("s_waitcnt lgkmcnt(8)" ::: "memory"); SBAR(); pv_mma(o[0], fa, pa0, pa1, pa2, pa3); SBAR();
    v_rd8<2>(fa, vb);
    asm volatile("s_waitcnt lgkmcnt(8)" ::: "memory"); SBAR(); pv_mma(o[1], fb, pa0, pa1, pa2, pa3); SBAR();
    v_rd8<3>(fb, vb);
    asm volatile("s_waitcnt lgkmcnt(8)" ::: "memory"); SBAR(); pv_mma(o[2], fa, pa0, pa1, pa2, pa3); SBAR();
    asm volatile("s_waitcnt lgkmcnt(0)" ::: "memory"); SBAR(); pv_mma(o[3], fb, pa0, pa1, pa2, pa3);
    __builtin_amdgcn_s_setprio(0);
}
__device__ __forceinline__ void pv_psm(f32x16* o, int vb, bf16x8 pa0, bf16x8 pa1, bf16x8 pa2, bf16x8 pa3, f32x16& p0, f32x16& p1, float& m_reg, float& alpha) {
    constexpr float C = SCALE * 1.4426950408889634f;
    s16x4 fa[8], fb[8];
    __builtin_amdgcn_s_setprio(1);
    v_rd8<0>(fa, vb); v_rd8<1>(fb, vb);
    asm volatile("s_waitcnt lgkmcnt(8)" ::: "memory"); SBAR(); pv_mma(o[0], fa, pa0, pa1, pa2, pa3);
    float pmax = p0[0];
#pragma unroll
    for (int r = 1; r < 16; ++r) pmax = fmaxf(pmax, p0[r]);
    SBAR();
    v_rd8<2>(fa, vb);
    asm volatile("s_waitcnt lgkmcnt(8)" ::: "memory"); SBAR(); pv_mma(o[1], fb, pa0, pa1, pa2, pa3);
#pragma unroll
    for (int r = 0; r < 16; ++r) pmax = fmaxf(pmax, p1[r]);
    { auto rr = __builtin_amdgcn_permlane32_swap(__float_as_uint(pmax), __float_as_uint(pmax), false, false); pmax = fmaxf(__uint_as_float(rr[0]), __uint_as_float(rr[1])); }
    const bool keep = __all(pmax - m_reg <= THR / SCALE);
    const float mn = keep ? m_reg : fmaxf(m_reg, pmax);
    alpha = keep ? 1.f : __builtin_amdgcn_exp2f((m_reg - mn) * C);
    m_reg = mn;
    const float mnC = -mn * C;
    SBAR();
    v_rd8<3>(fb, vb);
    asm volatile("s_waitcnt lgkmcnt(8)" ::: "memory"); SBAR(); pv_mma(o[2], fa, pa0, pa1, pa2, pa3);
#pragma unroll
    for (int r = 0; r < 16; ++r) p0[r] = fmaf(p0[r], C, mnC);
#pragma unroll
    for (int r = 0; r < 16; ++r) p1[r] = fmaf(p1[r], C, mnC);
    SBAR();
    asm volatile("s_waitcnt lgkmcnt(0)" ::: "memory"); SBAR(); pv_mma(o[3], fb, pa0, pa1, pa2, pa3);
#pragma unroll
    for (int r = 0; r < 16; ++r) p0[r] = __builtin_amdgcn_exp2f(p0[r]);
    __builtin_amdgcn_s_setprio(0);
}
__device__ __forceinline__ void attn_unit(int h, int q0, const bf16_t* __restrict__ Q, const bf16_t* __restrict__ KV, const bf16_t* __restrict__ KR, bf16_t* __restrict__ O, char* lds, LAS unsigned char* ldsl, int tid_in) {
    int tid = tid_in; asm volatile("" : "+v"(tid));
    const int wid = tid >> 6, lane = tid & 63, r32 = lane & 31, hi = lane >> 5;
    char* V_lds = lds + LDS_V; char* K_lds = lds + LDS_K;
    float* ws = (float*)(lds + LDS_WS) + wid * 64; float* li_l = ws; float* al_l = ws + 32;
    float m_reg = -1e30f, l_reg = 0.f; f32x16 o[4] = {}; bf16x8 qr[8];
    const bf16_t* Qw = Q + ((size_t)h * S + q0 + wid * 32 + r32) * 192 + hi * 8;
#pragma unroll
    for (int d0 = 0; d0 < 8; ++d0) qr[d0] = *reinterpret_cast<const bf16x8*>(Qw + d0 * 16);
    char* qrl = lds + LDS_QR + wid * (32 * 144) + r32 * 144 + hi * 16;
#pragma unroll
    for (int d0 = 8; d0 < 12; ++d0) *reinterpret_cast<bf16x8*>(qrl + (d0 - 8) * 32) = *reinterpret_cast<const bf16x8*>(Qw + d0 * 16);
    const bf16_t* Kh = KV + (size_t)h * S * 128; const bf16_t* Vh = KV + (size_t)(8 + h) * S * 128;
    const int vb0 = (int)(uintptr_t)V_lds + v_rd_base(lane);
    const int widu = __builtin_amdgcn_readfirstlane(wid);
    const char* gK0; const char* gK1; const char* gK2; unsigned iK0, iK1, iK2;
#define KSRC(t, G, I) do { const int ci_ = (widu + 8 * (t)) * 64 + lane; const int row_ = ci_ / 25; int ch_ = ci_ - row_ * 25; if (ch_ == 24) ch_ = 0; \
    if (ch_ < 16) { G = (const char*)(Kh + (size_t)row_ * 128 + ch_ * 8); I = 16384u; } else { G = (const char*)(KR + (size_t)row_ * 64 + (ch_ - 16) * 8); I = 8192u; } } while (0)
    KSRC(0, gK0, iK0); KSRC(1, gK1, iK1); KSRC(2, gK2, iK2);
    unsigned voffV0;
#define VSRC(t, V_) do { const int st_ = 2 * (widu + 8 * (t)) + (lane >> 5); const int kk_ = (st_ >> 2) * 8 + ((lane & 31) >> 2); const int k_ = (kk_ & ~0xC) | ((kk_ & 4) << 1) | ((kk_ & 8) >> 1); \
    const int c_ = (st_ & 3) * 32 + (lane & 3) * 8; V_ = (unsigned)(k_ * 128 + c_) * 2u; } while (0)
    VSRC(0, voffV0);
#undef VSRC
    LAS unsigned char* Kd = ldsl + LDS_K + widu * 1024; LAS unsigned char* Vd = ldsl + LDS_V + widu * 1024;
#define DMA_TILE(kt, kb, vs) do { const char* vt_ = (const char*)(Vh + (size_t)(kt) * 64 * 128); \
    __builtin_amdgcn_global_load_lds((const unsigned*)gK0, (LAS unsigned*)(Kd + (kb) * SHM_K), 16, 0, 0); gK0 += iK0; \
    __builtin_amdgcn_global_load_lds((const unsigned*)gK1, (LAS unsigned*)(Kd + (kb) * SHM_K + 8192), 16, 0, 0); gK1 += iK1; \
    __builtin_amdgcn_global_load_lds((const unsigned*)gK2, (LAS unsigned*)(Kd + (kb) * SHM_K + 16384), 16, 0, 0); gK2 += iK2; \
    if (widu == 0) { const char* g3_; unsigned i3_; KSRC(3, g3_, i3_); g3_ += (size_t)(kt) * i3_; __builtin_amdgcn_global_load_lds((const unsigned*)g3_, (LAS unsigned*)(Kd + (kb) * SHM_K + 24576), 16, 0, 0); } \
    __builtin_amdgcn_global_load_lds((const unsigned*)(vt_ + voffV0), (LAS unsigned*)(Vd + (vs) * SHM_V), 16, 0, 0); \
    __builtin_amdgcn_global_load_lds((const unsigned*)(vt_ + 8192 + voffV0), (LAS unsigned*)(Vd + (vs) * SHM_V + 8192), 16, 0, 0); } while (0)
#define RESC(a_) do { if (__any((a_) != 1.f)) { if (hi == 0) al_l[r32] = (a_); asm volatile("s_waitcnt lgkmcnt(0)" ::: "memory"); \
    _Pragma("unroll") for (int d = 0; d < 4; ++d) _Pragma("unroll") for (int r = 0; r < 16; ++r) o[d][r] *= al_l[crow(r, hi)]; } } while (0)
#define LANDED() do { asm volatile("s_waitcnt vmcnt(0)" ::: "memory"); __syncthreads(); } while (0)
    f32x16 pA0, pA1, pB0, pB1; float mnA, mnB, alA, alB; bf16x8 pa0, pa1, pa2, pa3; const int NT = S / KVBLK;
    DMA_TILE(0, 0, 0); LANDED();
    DMA_TILE(1, 1, 1);
    qkt(pA0, pA1, K_lds, qr, qrl, r32, hi); partialSM(pA0, pA1, m_reg, mnA, alA);
    LANDED();
    int vprev = 0, vnext = 2;
#define VROT() do { vprev = (vprev == 2) ? 0 : vprev + 1; vnext = (vnext == 2) ? 0 : vnext + 1; } while (0)
    for (int j = 1; j + 1 < NT; j += 2) {
        DMA_TILE(j + 1, 0, vnext);
        SBAR(); qkt(pB0, pB1, K_lds + SHM_K, qr, qrl, r32, hi);
        finishSM(pA0, pA1, alA, l_reg, pa0, pa1, pa2, pa3); SBAR();
        pv_psm(o, vb0 + vprev * SHM_V, pa0, pa1, pa2, pa3, pB0, pB1, m_reg, alB);
        RESC(alB); LANDED(); VROT();
        DMA_TILE(j + 2, 1, vnext);
        SBAR(); qkt(pA0, pA1, K_lds, qr, qrl, r32, hi);
        finishSM(pB0, pB1, alB, l_reg, pa0, pa1, pa2, pa3); SBAR();
        pv_psm(o, vb0 + vprev * SHM_V, pa0, pa1, pa2, pa3, pA0, pA1, m_reg, alA);
        RESC(alA); LANDED(); VROT();
    }
    SBAR(); qkt(pB0, pB1, K_lds + SHM_K, qr, qrl, r32, hi);
    finishSM(pA0, pA1, alA, l_reg, pa0, pa1, pa2, pa3); SBAR();
    pv_d0(o, vb0 + vprev * SHM_V, pa0, pa1, pa2, pa3); partialSM(pB0, pB1, m_reg, mnB, alB);
    RESC(alB);
    finishSM(pB0, pB1, alB, l_reg, pa0, pa1, pa2, pa3); SBAR();
    pv_d0(o, vb0 + ((vprev == 2) ? 0 : vprev + 1) * SHM_V, pa0, pa1, pa2, pa3);
#undef VROT
#undef LANDED
#undef DMA_TILE
#undef KSRC
    { int tid2 = tid_in; asm volatile("" : "+v"(tid2));
      const int wid2 = tid2 >> 6, lane2 = tid2 & 63, r32b = lane2 & 31, hib = lane2 >> 5;
      float* li2 = (float*)(lds + LDS_WS) + wid2 * 64;
      if (hib == 0) li2[r32b] = l_reg; asm volatile("s_waitcnt lgkmcnt(0)" ::: "memory");
      float rli[16];
#pragma unroll
      for (int r = 0; r < 16; ++r) rli[r] = __builtin_amdgcn_rcpf(li2[crow(r, hib)]);
      bf16_t* Ow = O + (size_t)(q0 + wid2 * 32) * 1024 + h * 128;
#pragma unroll
      for (int r = 0; r < 16; ++r) { const int orow = crow(r, hib);
#pragma unroll
          for (int d0 = 0; d0 < 4; ++d0) { const float v = o[d0][r] * rli[r]; Ow[(size_t)orow * 1024 + d0 * 32 + r32b] = (bf16_t)(cvt_pk_bf16(v, v) & 0xffffu); } } }
    __syncthreads();
#undef RESC
}
#undef SBAR
}


namespace att8 {
constexpr int KVBLK = 64, KROW = 208, VROW = 80, SHM_K = 64 * KROW  , SHM_V = 128 * VROW  ;
constexpr int LDS_V = 0, LDS_K = 3 * SHM_V, LDS_WS = LDS_K + 2 * SHM_K, LDS_BYTES = LDS_WS + NW * 64 * 4;
constexpr float SCALE = 0.07216878364870323f;
constexpr float THR = 3.f, PSHIFT = 4.f;
__device__ __forceinline__ int crow(int r, int hi) { return (r & 3) + 8 * (r >> 2) + 4 * hi; }
#define MFMA8(a_, b_, c_) __builtin_amdgcn_mfma_scale_f32_32x32x64_f8f6f4(a_, b_, c_, 0, 0, 0, 0x7f7f7f7f, 0, 0x7f7f7f7f)
__device__ __forceinline__ v8i ld32(const char* p) { const u32x4 a = *reinterpret_cast<const u32x4*>(p), b = *reinterpret_cast<const u32x4*>(p + 16); return (v8i){(int)a.x, (int)a.y, (int)a.z, (int)a.w, (int)b.x, (int)b.y, (int)b.z, (int)b.w}; }
__device__ __forceinline__ void qkt(f32x16& p0, f32x16& p1, const char* Ks, const v8i* qf, const f32x16& negm, int r32, int hi) {
#pragma unroll
    for (int kk = 0; kk < 3; ++kk) { const v8i a0 = ld32(Ks + r32 * KROW + 64 * kk + 32 * hi), a1 = ld32(Ks + (32 + r32) * KROW + 64 * kk + 32 * hi);
        if (kk == 0) { p0 = MFMA8(a0, qf[0], negm); p1 = MFMA8(a1, qf[0], negm); } else { p0 = MFMA8(a0, qf[kk], p0); p1 = MFMA8(a1, qf[kk], p1); } }
}
__device__ __forceinline__ void partialSM(f32x16& p0, f32x16& p1, float& m_reg, f32x16& negm, float& alpha) {
    constexpr float THRL = THR * 1.4426950408889634f;
    float pmax = p0[0];
#pragma unroll
    for (int r = 1; r < 16; ++r) pmax = fmaxf(pmax, p0[r]);
#pragma unroll
    for (int r = 0; r < 16; ++r) pmax = fmaxf(pmax, p1[r]);
    { auto rr = __builtin_amdgcn_permlane32_swap(__float_as_uint(pmax), __float_as_uint(pmax), false, false); pmax = fmaxf(__uint_as_float(rr[0]), __uint_as_float(rr[1])); }
    alpha = 1.f;
    if (__builtin_expect(!__all(pmax <= PSHIFT + THRL), 0)) {
        const float dl = fmaxf(pmax - PSHIFT, 0.f);
        m_reg += dl; alpha = __builtin_amdgcn_exp2f(-dl);
#pragma unroll
        for (int r = 0; r < 16; ++r) { p0[r] -= dl; p1[r] -= dl; }
        const float nm = PSHIFT - m_reg;
#pragma unroll
        for (int r = 0; r < 16; ++r) negm[r] = nm;
    }
#pragma unroll
    for (int r = 0; r < 16; ++r) p0[r] = __builtin_amdgcn_exp2f(p0[r]);
}
__device__ __forceinline__ void finishSM(f32x16& p0, f32x16& p1, v8i& pf) {
#pragma unroll
    for (int r = 0; r < 16; ++r) p1[r] = __builtin_amdgcn_exp2f(p1[r]);
#pragma unroll
    for (int i = 0; i < 4; ++i) { const unsigned x = pk4_fp8((f32x4){p0[4 * i], p0[4 * i + 1], p0[4 * i + 2], p0[4 * i + 3]}), y = pk4_fp8((f32x4){p1[4 * i], p1[4 * i + 1], p1[4 * i + 2], p1[4 * i + 3]});
        auto rr = __builtin_amdgcn_permlane32_swap(x, y, false, false); pf[2 * i] = (int)rr[0]; pf[2 * i + 1] = (int)rr[1]; }
}
__device__ __forceinline__ void pv(f32x16* o, const char* Vs, v8i pf, int r32, int hi) {
    const v8i ones = {0x38383838, 0x38383838, 0x38383838, 0x38383838, 0x38383838, 0x38383838, 0x38383838, 0x38383838};
    __builtin_amdgcn_s_setprio(1);
#pragma unroll
    for (int db = 0; db < 4; ++db) { const v8i b = ld32(Vs + (32 * db + r32) * VROW + 32 * hi); o[db] = MFMA8(pf, b, o[db]); }
    o[4] = MFMA8(pf, ones, o[4]);
    __builtin_amdgcn_s_setprio(0);
}
__device__ __forceinline__ void attn_unit(int h, int q0, const unsigned char* __restrict__ Q8, const unsigned char* __restrict__ K8, const unsigned char* __restrict__ KR8, const unsigned char* __restrict__ V8T,
                                          bf16_t* __restrict__ O, char* lds, LAS unsigned char* ldsl, int tid_in) {
    int tid = tid_in; asm volatile("" : "+v"(tid));
    const int wid = tid >> 6, lane = tid & 63, r32 = lane & 31, hi = lane >> 5;
    const int widu = __builtin_amdgcn_readfirstlane(wid);
    char* V_lds = lds + LDS_V; char* K_lds = lds + LDS_K;
    float* ws = (float*)(lds + LDS_WS) + wid * 64; float* al_l = ws + 32;
    float m_reg = 0.f; f32x16 o[5] = {}; v8i qf[3]; f32x16 negm;
#pragma unroll
    for (int r = 0; r < 16; ++r) negm[r] = PSHIFT;
    { const char* Qrow = (const char*)(Q8 + ((size_t)h * S + q0 + wid * 32 + r32) * 192 + 32 * hi);
#pragma unroll
      for (int kk = 0; kk < 3; ++kk) qf[kk] = ld32(Qrow + 64 * kk); }
    const char* gKa; const char* gKb; unsigned iKa, iKb;
#define KSRC(P, G, I) do { const int ci_ = (P) * 64 + lane; const int row_ = ci_ / 13; int ch_ = ci_ - row_ * 13; if (ch_ == 12) ch_ = 0; \
    if (ch_ < 8) { G = (const char*)(K8 + (size_t)row_ * 1024 + h * 128 + ch_ * 16); I = 65536u; } else { G = (const char*)(KR8 + (size_t)row_ * 64 + (ch_ - 8) * 16); I = 4096u; } } while (0)
    KSRC(widu, gKa, iKa); KSRC((widu < 5 ? widu + 8 : widu), gKb, iKb);
#undef KSRC
    const int vq0 = (widu + 3) & 7;
    unsigned voffV0, voffV1;
#define VSRC(Qp, V_) do { const int ci_ = (Qp) * 64 + lane; const int row_ = ci_ / 5; int ch_ = ci_ - row_ * 5; if (ch_ == 4) ch_ = 0; V_ = (unsigned)(row_ * S + ch_ * 16); } while (0)
    VSRC(vq0, voffV0); VSRC((vq0 < 2 ? vq0 + 8 : vq0), voffV1);
#undef VSRC
    const unsigned char* Vh = V8T + (size_t)h * 128 * S;
    LAS unsigned char* Kd = ldsl + LDS_K; LAS unsigned char* Vd = ldsl + LDS_V;
#define DMA_TILE(kt, kb, vs) do { const char* vt_ = (const char*)(Vh + (size_t)(kt) * 64); \
    __builtin_amdgcn_global_load_lds((const unsigned*)gKa, (LAS unsigned*)(Kd + (kb) * SHM_K + widu * 1024), 16, 0, 0); gKa += iKa; \
    if (widu < 5) { __builtin_amdgcn_global_load_lds((const unsigned*)gKb, (LAS unsigned*)(Kd + (kb) * SHM_K + (widu + 8) * 1024), 16, 0, 0); gKb += iKb; } \
    __builtin_amdgcn_global_load_lds((const unsigned*)(vt_ + voffV0), (LAS unsigned*)(Vd + (vs) * SHM_V + vq0 * 1024), 16, 0, 0); \
    if (vq0 < 2) __builtin_amdgcn_global_load_lds((const unsigned*)(vt_ + voffV1), (LAS unsigned*)(Vd + (vs) * SHM_V + (vq0 + 8) * 1024), 16, 0, 0); } while (0)
#define RESC(a_) do { if (__any((a_) != 1.f)) { if (hi == 0) al_l[r32] = (a_); asm volatile("s_waitcnt lgkmcnt(0)" ::: "memory"); \
    _Pragma("unroll") for (int d = 0; d < 5; ++d) _Pragma("unroll") for (int r = 0; r < 16; ++r) o[d][r] *= al_l[crow(r, hi)]; } } while (0)
#define LANDED() do { asm volatile("s_waitcnt vmcnt(0)" ::: "memory"); __syncthreads(); } while (0)
    f32x16 pA0, pA1, pB0, pB1; float alA, alB; v8i pf; const int NT = S / KVBLK;
    DMA_TILE(0, 0, 0); LANDED();
    DMA_TILE(1, 1, 1);
    qkt(pA0, pA1, K_lds, qf, negm, r32, hi); partialSM(pA0, pA1, m_reg, negm, alA);
    LANDED();
    int vprev = 0, vnext = 2;
#define VROT() do { vprev = (vprev == 2) ? 0 : vprev + 1; vnext = (vnext == 2) ? 0 : vnext + 1; } while (0)
    for (int j = 1; j + 1 < NT; j += 2) {
        DMA_TILE(j + 1, 0, vnext);
        qkt(pB0, pB1, K_lds + SHM_K, qf, negm, r32, hi);
        finishSM(pA0, pA1, pf);
        pv(o, V_lds + vprev * SHM_V, pf, r32, hi); partialSM(pB0, pB1, m_reg, negm, alB);
        RESC(alB); LANDED(); VROT();
        DMA_TILE(j + 2, 1, vnext);
        qkt(pA0, pA1, K_lds, qf, negm, r32, hi);
        finishSM(pB0, pB1, pf);
        pv(o, V_lds + vprev * SHM_V, pf, r32, hi); partialSM(pA0, pA1, m_reg, negm, alA);
        RESC(alA); LANDED(); VROT();
    }
    qkt(pB0, pB1, K_lds + SHM_K, qf, negm, r32, hi);
    finishSM(pA0, pA1, pf);
    pv(o, V_lds + vprev * SHM_V, pf, r32, hi); partialSM(pB0, pB1, m_reg, negm, alB);
    RESC(alB);
    finishSM(pB0, pB1, pf);
    pv(o, V_lds + ((vprev == 2) ? 0 : vprev + 1) * SHM_V, pf, r32, hi);
#undef VROT
#undef LANDED
#undef DMA_TILE
    { int tid2 = tid_in; asm volatile("" : "+v"(tid2));
      const int wid2 = tid2 >> 6, lane2 = tid2 & 63, r32b = lane2 & 31, hib = lane2 >> 5;
      float rli[16];
#pragma unroll
      for (int r = 0; r < 16; ++r) rli[r] = __builtin_amdgcn_rcpf(o[4][r]);
      char* stg = lds + 65536 + wid2 * 8704;
#pragma unroll
      for (int r = 0; r < 16; ++r) { const int orow = crow(r, hib);
#pragma unroll
          for (int d0 = 0; d0 < 4; ++d0) { const float v = o[d0][r] * rli[r]; *(bf16_t*)(stg + orow * 272 + (d0 * 32 + r32b) * 2) = (bf16_t)(cvt_pk_bf16(v, v) & 0xffffu); } }
      asm volatile("s_waitcnt lgkmcnt(0)" ::: "memory");
      bf16_t* Ow = O + (size_t)(q0 + wid2 * 32) * 1536 + h * 128;
#pragma unroll
      for (int i = 0; i < 8; ++i) { const int row = i * 4 + (lane2 >> 4), ch = lane2 & 15; const u32x4 v = *(const u32x4*)(stg + row * 272 + ch * 16); *(u32x4*)(Ow + (size_t)row * 1536 + ch * 8) = v; }
      asm volatile("s_waitcnt lgkmcnt(0)" ::: "memory"); }
    __syncthreads();
#undef RESC
#undef MFMA8
}
}

struct Args { const float* in[21]; float* out; unsigned char* ws; float inv_freq[32]; int grid; int pad; };
constexpr int LDS_BYTES = 147456;

enum { I_X = 0, I_EWIN, I_EQN, I_EWUQ, I_EKVN, I_EWUK, I_EWUV, I_EWOUT, I_OWIN, I_ONG, I_ONB, I_OWSP, I_OBSP, I_OWOUT, I_MLG, I_MLB, I_FWG, I_FWU, I_FWD, I_FLG, I_FLB };

struct Ctx { LAS unsigned char* lds; int tid, lane, wave, gw, NGW, G; };
__device__ __forceinline__ const float* inp(const Args& a, int idx) { (void)a; const Args* ap = launder_p((const Args*)(uintptr_t)__builtin_amdgcn_kernarg_segment_ptr()); return launder_p(ap->in[idx]); }


template <bool OUT_F16> __device__ __forceinline__ void tr_block(const float* src, int ld, bf16_t* dst, int ldt, LAS float* scr, int lane) {
    f32x4 v[8]; const int lr = lane >> 3, lc = 4 * (lane & 7);
#pragma unroll
    for (int i = 0; i < 8; ++i) v[i] = *(const f32x4*)(src + (size_t)(i * 8 + lr) * ld + lc);
#pragma unroll
    for (int i = 0; i < 8; ++i) { LAS float* p = scr + (i * 8 + lr) * 33 + lc; p[0] = v[i][0]; p[1] = v[i][1]; p[2] = v[i][2]; p[3] = v[i][3]; }
    asm volatile("s_waitcnt lgkmcnt(0)" ::: "memory");
    const int c = lane & 7;
#pragma unroll
    for (int j = 0; j < 4; ++j) { const int n = (lane >> 3) + 8 * j; const LAS float* s = scr + (8 * c) * 33 + n;
        u32x4 o; if constexpr (OUT_F16) { o.x = cvt_pk_f16(s[0 * 33], s[1 * 33]); o.y = cvt_pk_f16(s[2 * 33], s[3 * 33]); o.z = cvt_pk_f16(s[4 * 33], s[5 * 33]); o.w = cvt_pk_f16(s[6 * 33], s[7 * 33]); }
        else { o.x = cvt_pk_bf16(s[0 * 33], s[1 * 33]); o.y = cvt_pk_bf16(s[2 * 33], s[3 * 33]); o.z = cvt_pk_bf16(s[4 * 33], s[5 * 33]); o.w = cvt_pk_bf16(s[6 * 33], s[7 * 33]); }
        *(u32x4*)(dst + (size_t)n * ldt + 8 * c) = o; }
    asm volatile("s_waitcnt lgkmcnt(0)" ::: "memory");
}
template <int MODE, int HALFSEL, bool OUT_F16 = false>
__device__ __forceinline__ void tr_job(const Ctx& F, const float* src, int ld, int K, int ncb, bf16_t* dst, int ldt) {
    LAS float* scr = (LAS float*)(F.lds + F.wave * 16384);
    const int nitems = (K / 64) * ncb;
    for (int it = F.gw; it < nitems; it += F.NGW) { const int kb = it / ncb, nb = it % ncb; int scol, drow;
        if (MODE == 0) { scol = 32 * nb; drow = 32 * nb; }
        else if (MODE == 1) { drow = 32 * nb; if (drow < 1024) { scol = (drow >> 7) * 192 + (drow & 127); } else { const int x = drow - 1024, r = x >> 8, hf = (x >> 7) & 1, j = x & 127; scol = (4 * r + (j >> 5)) * 192 + 128 + hf * 32; } }
        else { scol = 32 * nb; drow = 256 * (scol >> 7) + HALFSEL * 128 + (scol & 127); }
        tr_block<OUT_F16>(src + (size_t)kb * 64 * ld + scol, ld, dst + (size_t)drow * ldt + kb * 64, ldt, scr, F.lane); }
}
__device__ __forceinline__ void convert_ffn(const Ctx& F, const Args& a, int layer) {
    unsigned char* wsl = launder_p(launder_p((const Args*)(uintptr_t)__builtin_amdgcn_kernarg_segment_ptr())->ws); bf16_t* gu = (bf16_t*)(wsl + WS_WFFN + WF_GU); bf16_t* dn = (bf16_t*)(wsl + WS_WFFN + WF_DN);
    tr_job<2, 0, true>(F, inp(a, I_FWG) + (size_t)layer * DM * DFF, DFF, DM, DFF / 32, gu, DM);
    tr_job<2, 1, true>(F, inp(a, I_FWU) + (size_t)layer * DM * DFF, DFF, DM, DFF / 32, gu, DM);
    tr_job<0, 0>(F, inp(a, I_FWD) + (size_t)layer * DFF * DM, DM, DFF, DM / 32, dn, DFF);
}
__device__ __forceinline__ void convert_odd(const Ctx& F, const Args& a, int i) {
    unsigned char* w = launder_p(launder_p((const Args*)(uintptr_t)__builtin_amdgcn_kernarg_segment_ptr())->ws) + WS_WMIX;
    tr_job<0, 0, true>(F, inp(a, I_OWIN) + (size_t)i * DM * 4096, 4096, DM, 4096 / 32, (bf16_t*)(w + WO_IN), DM);
    tr_job<0, 0>(F, inp(a, I_OWOUT) + (size_t)i * 2048 * DM, DM, 2048, DM / 32, (bf16_t*)(w + WO_OUT), 2048);
    const float* wsp = inp(a, I_OWSP) + (size_t)i * 8 * 128 * 128; bf16_t* d = (bf16_t*)(w + WO_SP);
    for (int e = (F.gw * 64 + F.lane) * 4; e < 8 * 128 * 128; e += F.NGW * 64 * 4) { const f32x4 v = *(const f32x4*)(wsp + e); u32x2 o; o.x = cvt_pk_bf16(v[0], v[1]); o.y = cvt_pk_bf16(v[2], v[3]); *(u32x2*)(d + e) = o; }
}
__device__ __forceinline__ void convert_even(const Ctx& F, const Args& a, int i) {
    unsigned char* w = launder_p(launder_p((const Args*)(uintptr_t)__builtin_amdgcn_kernarg_segment_ptr())->ws) + WS_WMIX;
    const float* win = inp(a, I_EWIN) + (size_t)i * DM * 1216;
    tr_job<0, 0, true>(F, win, 1216, DM, 704 / 32, (bf16_t*)(w + WE_INN), DM);
    { bf16_t* z = (bf16_t*)(w + WE_INN) + (size_t)704 * DM;
      for (int e = (F.gw * 64 + F.lane) * 8; e < 64 * DM; e += F.NGW * 64 * 8) *(u32x4*)(z + e) = (u32x4){0u, 0u, 0u, 0u}; }
    tr_job<1, 0>(F, inp(a, I_EWUQ) + (size_t)i * 384 * 1536, 1536, 384, 1536 / 32, (bf16_t*)(w + WE_Q), 384);
    tr_job<0, 0>(F, inp(a, I_EWUK) + (size_t)i * 256 * 1024, 1024, 256, 1024 / 32, (bf16_t*)(w + WE_KV), 256);
    tr_job<0, 0>(F, inp(a, I_EWUV) + (size_t)i * 256 * 1024, 1024, 256, 1024 / 32, (bf16_t*)(w + WE_KV) + (size_t)1024 * 256, 256);
    const float* wout = inp(a, I_EWOUT) + (size_t)i * 1536 * DM;
    tr_job<0, 0>(F, wout, DM, 1536, DM / 32, (bf16_t*)(w + WE_OUTA), 1536);
    LAS float* tab = (LAS float*)(F.lds + 131072);
    bf16_t* wf = (bf16_t*)(w + WE_INF);
    for (int t = F.gw; t < 16 * 512; t += F.NGW) { const int kblk = t >> 9, gj = t & 511, g = gj >> 7, j = gj & 127; const int k = kblk * 64 + F.lane;
        const float* wr_ = win + (size_t)k * 1216 + 704 + g * 128; float p = 0.f, q = 0.f;
#pragma unroll 4
        for (int ch = 0; ch < 128; ch += 4) { const f32x4 v = *(const f32x4*)(wr_ + ch);
#pragma unroll
            for (int e = 0; e < 4; ++e) { const int idx = ((ch + e) * j) & 127; p = fmaf(v[e], tab[idx], p); q = fmaf(v[e], tab[128 + idx], q); } }
        wf[(size_t)(gj * 2) * DM + k] = (bf16_t)(cvt_pk_f16(p, p) & 0xffffu); wf[(size_t)(gj * 2 + 1) * DM + k] = (bf16_t)(cvt_pk_f16(q, q) & 0xffffu); }
}
__device__ __forceinline__ void ln_rows(const Ctx& F, float* x, bf16_t* xb, const float* g, const float* b) {
    f32x4 gv[4], bv[4];
#pragma unroll
    for (int j = 0; j < 4; ++j) { gv[j] = *(const f32x4*)(g + 4 * F.lane + 256 * j); bv[j] = *(const f32x4*)(b + 4 * F.lane + 256 * j); }
    for (int m = F.gw; m < S; m += F.NGW) { float* xr = x + (size_t)m * DM + 4 * F.lane; f32x4 v[4]; float s = 0.f;
#pragma unroll
        for (int j = 0; j < 4; ++j) { v[j] = *(const f32x4*)(xr + 256 * j); s += (v[j][0] + v[j][1]) + (v[j][2] + v[j][3]); }
        const float mean = wave_sum(s, F.lane) * (1.f / DM); float s2 = 0.f;
#pragma unroll
        for (int j = 0; j < 4; ++j) { v[j] = v[j] - mean; s2 += (v[j][0] * v[j][0] + v[j][1] * v[j][1]) + (v[j][2] * v[j][2] + v[j][3] * v[j][3]); }
        const float rstd = 1.f / sqrtf(wave_sum(s2, F.lane) * (1.f / DM) + LN_EPS);
        bf16_t* br = xb + (size_t)m * DM + 4 * F.lane;
#pragma unroll
        for (int j = 0; j < 4; ++j) { const f32x4 o = v[j] * rstd * gv[j] + bv[j]; *(f32x4*)(xr + 256 * j) = o; u32x2 w; w.x = cvt_pk_bf16(o[0], o[1]); w.y = cvt_pk_bf16(o[2], o[3]); *(u32x2*)(br + 256 * j) = w; } }
}

#define PHASE_BEGIN() \
    Ctx F; { const int b_ = launder_i(blockIdx.x); \
      F.lds = (LAS unsigned char*)lds_raw; F.lane = hw_lane(); F.wave = hw_wave(F.lds); F.tid = F.wave * 64 + F.lane; F.G = 0; F.gw = b_ * NW + F.wave; F.NGW = 0; } \
    const int bx = (F.gw - F.wave) / NW; (void)bx; \
    const Args* ap_ = launder_p((const Args*)(uintptr_t)__builtin_amdgcn_kernarg_segment_ptr()); unsigned char* ws = launder_p(ap_->ws); F.G = launder_i(ap_->grid); F.NGW = F.G * NW; unsigned char* act = ws + WS_ACT; (void)act; \
    float* xres = launder_p(ap_->out); bf16_t* xb = (bf16_t*)(ws + WS_XB); (void)xb; (void)xres; \
    unsigned char* w = ws + WS_WMIX; (void)w; \
    float* ropeC = (float*)(ws + WS_ROPEC); float* ropeS = (float*)(ws + WS_ROPES); f32x2* tw = (f32x2*)(ws + WS_TW); bf16_t* fst = (bf16_t*)(ws + WS_FST); (void)ropeC; (void)ropeS; (void)tw; (void)fst;


#define XB_TMO      128
#define XB_XCNT(j)  (256  + 64 * (j))
#define XB_XSUB(j)  (1280 + 64 * (j))
#define XB_XGEN(j)  (2304 + 64 * (j))
#define XB_TOP      3328
#define XB_TOPGEN   3392
#define XB_SPIN_CAP (1u << 22)
constexpr size_t WS_BAR = 16384, WS_LNCNT = 65536, WS_LNX = 262144, WS_CLNCNT = 196608, WS_CLNX = 5 * MiB + 512 * 1024;
constexpr int XB_LDS_OFF = 147456 - 512;
__device__ __forceinline__ unsigned xb_ld(unsigned* p)              { return __hip_atomic_load(p, __ATOMIC_RELAXED, __HIP_MEMORY_SCOPE_AGENT); }
__device__ __forceinline__ unsigned xb_add(unsigned* p, unsigned v) { return __hip_atomic_fetch_add(p, v, __ATOMIC_RELAXED, __HIP_MEMORY_SCOPE_AGENT); }
__device__ __forceinline__ unsigned xb_xcc_id() { return (unsigned)__builtin_amdgcn_s_getreg((3 << 11) | 20) & 0xFu; }
#define XB_SPIN(cond, bar) do { unsigned _sp = 0; while (cond) { __builtin_amdgcn_s_sleep(1); \
    if ((++_sp & 255u) == 0u) { if (xb_ld(&(bar)[XB_TMO])) break; if (_sp > XB_SPIN_CAP) { atomicAdd(&(bar)[XB_TMO], 1u); break; } } } } while (0)
__device__ __forceinline__ void xcd_barrier_complete(unsigned* bar, unsigned x, unsigned G, unsigned& nloc, unsigned& nx) {
    unsigned sum, cnt, mine, sp = 0u;
    for (;;) {
        sum = 0u; cnt = 0u; mine = 0u;
#pragma unroll
        for (unsigned j = 0; j < 16; ++j) { const unsigned c = xb_ld(&bar[XB_XCNT(j)]); sum += c; cnt += (c > 0u) ? 1u : 0u; mine = (j == x) ? c : mine; }
        if (sum == G) break;
        __builtin_amdgcn_s_sleep(1);
        if ((++sp & 255u) == 0u) { if (xb_ld(&bar[XB_TMO])) break; if (sp > XB_SPIN_CAP) { atomicAdd(&bar[XB_TMO], 1u); break; } }
    }
    nloc = mine > 0u ? mine : 1u; nx = cnt > 0u ? cnt : 1u;
}
__device__ __forceinline__ void xcd_barrier(unsigned char* wsb, LAS unsigned char* lds, int tid, unsigned G) {
    asm volatile("s_waitcnt vmcnt(0)" ::: "memory");
    __syncthreads();
    if (tid == 0) {
        unsigned* bar = (unsigned*)(wsb + WS_BAR); volatile LAS unsigned* st = (volatile LAS unsigned*)(lds + XB_LDS_OFF);
        const unsigned x = xb_xcc_id();
        __builtin_amdgcn_s_waitcnt(0);
        unsigned nloc = st[0], nx = st[1];
        if (nloc == 0u) { xcd_barrier_complete(bar, x, G, nloc, nx); st[0] = nloc; st[1] = nx; }
        const unsigned old = xb_add(&bar[XB_XSUB(x)], 1u);
        const unsigned gen = old / nloc;
        if (old + 1u == (gen + 1u) * nloc) {
            __builtin_amdgcn_fence(__ATOMIC_RELEASE, "agent");
            asm volatile("s_waitcnt vmcnt(0)" ::: "memory");
            const unsigned og = xb_add(&bar[XB_TOP], 1u);
            const unsigned tg = og / nx;
            if (og + 1u == (tg + 1u) * nx) xb_add(&bar[XB_TOPGEN], 1u);
            else XB_SPIN(xb_ld(&bar[XB_TOPGEN]) == tg, bar);
            __builtin_amdgcn_fence(__ATOMIC_ACQUIRE, "agent");
            xb_add(&bar[XB_XGEN(x)], 1u);
            asm volatile("s_waitcnt vmcnt(0)" ::: "memory");
        } else {
            XB_SPIN(xb_ld(&bar[XB_XGEN(x)]) == gen, bar);
            __builtin_amdgcn_fence(__ATOMIC_ACQUIRE, "agent");
            asm volatile("s_waitcnt vmcnt(0)" ::: "memory");
        }
    }
    __syncthreads();
}
#define GSYNC() do { PHASE_BEGIN(); xcd_barrier(ws, F.lds, F.tid, (unsigned)F.G); } while (0)

#ifdef PROBE_BUILD
__device__ __forceinline__ float blk_sum(float v, LAS float* red, int tid) { __syncthreads(); red[tid] = v; __syncthreads(); for (int o = 256; o > 0; o >>= 1) { if (tid < o) red[tid] += red[tid + o]; __syncthreads(); } const float r = red[0]; __syncthreads(); return r; }
__device__ __forceinline__ float blk_max(float v, LAS float* red, int tid) { __syncthreads(); red[tid] = v; __syncthreads(); for (int o = 256; o > 0; o >>= 1) { if (tid < o) red[tid] = fmaxf(red[tid], red[tid + o]); __syncthreads(); } const float r = red[0]; __syncthreads(); return r; }
__device__ __forceinline__ void probe_flag(unsigned char* ws, float e, float n, unsigned bit, int tid) { if (tid == 0 && !(e <= 4e-4f * n)) atomicOr((unsigned*)ws, bit); }
__device__ __forceinline__ void probe_a(const Ctx& F, const Args& a, unsigned char* ws, int bx) {
    if (bx >= 8) return;
    const int tid = F.tid, s = (bx * 2053 + 77) & (S - 1);
    unsigned char* act = ws + WS_ACT; LAS float* red = (LAS float*)F.lds; LAS float* hrow = red + 512; LAS float* sc = hrow + 768;
    const bf16_t* xb = (const bf16_t*)(ws + WS_XB); const float* win = inp(a, I_EWIN); const float* hb = (const float*)(act + A_HBUF);
    float e = 0.f, n = 0.f;
    for (int t = tid; t < 704; t += 512) { float acc = 0.f; for (int k = 0; k < 1024; ++k) acc += bf2f(xb[(size_t)s * 1024 + k]) * win[(size_t)k * 1216 + t]; hrow[t] = acc; const float g = hb[(size_t)s * 768 + t]; e += (g - acc) * (g - acc); n += acc * acc; }
    e = blk_sum(e, red, tid); n = blk_sum(n, red, tid); probe_flag(ws, e, n, 1u, tid);
    if (tid == 0) { float q = 0.f, kv = 0.f; for (int k = 0; k < 384; ++k) q += hrow[k] * hrow[k]; for (int k = 384; k < 640; ++k) kv += hrow[k] * hrow[k]; sc[0] = 1.f / sqrtf(q / 384.f + RMS_EPS); sc[1] = 1.f / sqrtf(kv / 256.f + RMS_EPS); }
    __syncthreads();
    const float* qn = inp(a, I_EQN); const float* kvn = inp(a, I_EKVN); const bf16_t* cqn = (const bf16_t*)(act + A_CQN); const bf16_t* ckvn = (const bf16_t*)(act + A_CKVN);
    e = 0.f; n = 0.f;
    for (int t = tid; t < 640; t += 512) { float ref, g; if (t < 384) { ref = hrow[t] * sc[0] * qn[t]; g = bf2f(cqn[(size_t)s * 384 + t]); } else { ref = hrow[t] * sc[1] * kvn[t - 384]; g = bf2f(ckvn[(size_t)s * 256 + t - 384]); } e += (g - ref) * (g - ref); n += ref * ref; }
    e = blk_sum(e, red, tid); n = blk_sum(n, red, tid); probe_flag(ws, e, n, 2u, tid);
    const Args* ap = launder_p((const Args*)(uintptr_t)__builtin_amdgcn_kernarg_segment_ptr()); const bf16_t* kr = (const bf16_t*)(act + A_KR);
    e = 0.f; n = 0.f;
    if (tid < 64) { const int dd = tid & 31; const float ang = (float)s * ap->inv_freq[dd]; const float c = __cosf(ang), sn = __sinf(ang);
        const float ref = (tid < 32) ? hrow[640 + tid] * c - hrow[640 + tid + 32] * sn : hrow[640 + tid - 32] * sn + hrow[640 + tid] * c; const float g = bf2f(kr[(size_t)s * 64 + tid]); e = (g - ref) * (g - ref); n = ref * ref; }
    e = blk_sum(e, red, tid); n = blk_sum(n, red, tid); probe_flag(ws, e, n, 4u, tid);
}
__device__ __forceinline__ void probe_b(const Ctx& F, const Args& a, unsigned char* ws, int bx) {
    if (bx >= 8) return;
    const int tid = F.tid, s = (bx * 2053 + 77) & (S - 1), h = bx;
    unsigned char* act = ws + WS_ACT; LAS float* red = (LAS float*)F.lds; LAS float* qraw = red + 512; LAS float* part = qraw + 256; LAS float* p = part + 512;
    const bf16_t* cqn = (const bf16_t*)(act + A_CQN); const bf16_t* ckvn = (const bf16_t*)(act + A_CKVN); const bf16_t* Q = (const bf16_t*)(act + A_Q); const bf16_t* KV = (const bf16_t*)(act + A_KV); const bf16_t* KR = (const bf16_t*)(act + A_KR);
    const float* wuq = inp(a, I_EWUQ); const float* wuk = inp(a, I_EWUK); const float* wuv = inp(a, I_EWUV);
    const Args* ap = launder_p((const Args*)(uintptr_t)__builtin_amdgcn_kernarg_segment_ptr());
    if (tid < 192) { float acc = 0.f; for (int k = 0; k < 384; ++k) acc += bf2f(cqn[(size_t)s * 384 + k]) * wuq[(size_t)k * 1536 + h * 192 + tid]; qraw[tid] = acc; }
    __syncthreads();
    float e = 0.f, n = 0.f;
    if (tid < 192) { float ref = qraw[tid]; if (tid >= 128) { const int dd = (tid - 128) & 31; const float ang = (float)s * ap->inv_freq[dd]; const float c = __cosf(ang), sn = __sinf(ang);
            ref = (tid < 160) ? qraw[tid] * c - qraw[tid + 32] * sn : qraw[tid - 32] * sn + qraw[tid] * c; }
        const float g = bf2f(Q[((size_t)h * S + s) * 192 + tid]); e = (g - ref) * (g - ref); n = ref * ref; }
    e = blk_sum(e, red, tid); n = blk_sum(n, red, tid); probe_flag(ws, e, n, 8u, tid);
    e = 0.f; n = 0.f;
    if (tid < 256) { const int d = tid & 127; const float* wm = (tid < 128) ? wuk : wuv; float acc = 0.f; for (int k = 0; k < 256; ++k) acc += bf2f(ckvn[(size_t)s * 256 + k]) * wm[(size_t)k * 1024 + h * 128 + d];
        const float g = bf2f(KV[((size_t)((tid < 128 ? 0 : 8) + h) * S + s) * 128 + d]); e = (g - acc) * (g - acc); n = acc * acc; }
    e = blk_sum(e, red, tid); n = blk_sum(n, red, tid); probe_flag(ws, e, n, 16u, tid);
    if (tid < 192) qraw[tid] = bf2f(Q[((size_t)h * S + s) * 192 + tid]);
    __syncthreads();
    float mx = -1e30f;
    for (int i = 0; i < 32; ++i) { const int j = tid + 512 * i; float acc = 0.f; for (int d = 0; d < 128; ++d) acc += qraw[d] * bf2f(KV[((size_t)h * S + j) * 128 + d]); for (int d = 0; d < 64; ++d) acc += qraw[128 + d] * bf2f(KR[(size_t)j * 64 + d]); p[j] = acc; mx = fmaxf(mx, acc); }
    mx = blk_max(mx, red, tid);
    float sm = 0.f;
    for (int i = 0; i < 32; ++i) { const int j = tid + 512 * i; const float v = __expf((p[j] - mx) * 0.07216878364870323f); p[j] = v; sm += v; }
    sm = blk_sum(sm, red, tid);
    { const int d = tid & 127, pt = tid >> 7; float acc = 0.f; for (int j = pt * 4096; j < (pt + 1) * 4096; ++j) acc += p[j] * bf2f(KV[((size_t)(8 + h) * S + j) * 128 + d]); part[tid] = acc; }
    __syncthreads();
    e = 0.f; n = 0.f;
    if (tid < 128) { const float ref = (part[tid] + part[128 + tid] + part[256 + tid] + part[384 + tid]) / sm; const float g = bf2f(((const bf16_t*)(act + A_ATTNO))[(size_t)s * 1024 + h * 128 + tid]); e = (g - ref) * (g - ref); n = ref * ref; }
    e = blk_sum(e, red, tid); n = blk_sum(n, red, tid); probe_flag(ws, e, n, 32u, tid);
}
#endif

template <int layer> __device__ __forceinline__ void layer_body(const Args& a, unsigned char* lds_raw, cg::grid_group& grid) {
        const int li = layer >> 1;
        if (layer > 0) { PHASE_BEGIN(); convert_ffn(F, a, layer); __syncthreads(); }
        if ((layer & 1) == 0) {
            { PHASE_BEGIN();
              pg8::Gemm g{DM, DM, 128u * DM * 2u, 128u * DM * 2u, 1, DM}; pg8::StaticOrder So; So.init(S / 256, 3, F.G, bx, xres, (size_t)256 * DM * 2, w + WE_INN, (size_t)256 * DM * 2);
              pg8::EpiF16 E{(_Float16*)(act + A_HBUF), 768}; pg8::gemm_phase<true>(F.lds, g, So, E, F.tid); }
            { PHASE_BEGIN();
              pg8::Gemm g{DM, DM, 128u * DM * 2u, (unsigned)DM * 2u, 128, DM}; pg8::StaticOrder So; So.init(4, 64, F.G, bx, w + WE_INF, (size_t)256 * DM * 2, xres, (size_t)2 * DM * 2);
              pg8::EpiBf16<0> E{(bf16_t*)(act + A_ZT), (size_t)S}; pg8::gemm_phase<true>(F.lds, g, So, E, F.tid); }
            GSYNC();
            { PHASE_BEGIN();
              const _Float16* hb = (const _Float16*)(act + A_HBUF); bf16_t* cqn = (bf16_t*)(act + A_CQN); bf16_t* ckvn = (bf16_t*)(act + A_CKVN); bf16_t* kr = (bf16_t*)(act + A_KR);
              const float* qn = inp(a, I_EQN) + li * 384; const float* kvn = inp(a, I_EKVN) + li * 256;
              typedef float f32x8 __attribute__((ext_vector_type(8)));
              const int L = F.lane, l = L & 31, hf = L >> 5;
              const f32x8 g0 = *(const f32x8*)(qn + 8 * l);
              const f32x8 g1 = (l < 16) ? *(const f32x8*)(qn + 256 + 8 * l) : *(const f32x8*)(kvn + 8 * l - 128);
              const f32x8 g2 = (l < 16) ? *(const f32x8*)(kvn + 128 + 8 * l) : (f32x8){0.f, 0.f, 0.f, 0.f, 0.f, 0.f, 0.f, 0.f};
              for (int m0 = 2 * F.gw; m0 < S; m0 += 2 * F.NGW) { const int m = m0 + hf; const _Float16* hr = hb + (size_t)m * 768 + 8 * l;
                  const f32x8 v0 = __builtin_convertvector(*(const h16x8*)hr, f32x8), v1 = __builtin_convertvector(*(const h16x8*)(hr + 256), f32x8), v2 = __builtin_convertvector(*(const h16x8*)(hr + 512), f32x8);
                  float q0 = 0.f, q1 = 0.f, q2 = 0.f;
#pragma unroll
                  for (int e = 0; e < 8; ++e) { q0 += v0[e] * v0[e]; q1 += v1[e] * v1[e]; q2 += v2[e] * v2[e]; }
                  float sq = q0 + (l < 16 ? q1 : 0.f), skv = (l >= 16 ? q1 : 0.f) + (l < 16 ? q2 : 0.f);
#pragma unroll
                  for (int o = 1; o < 32; o <<= 1) { sq += shfl_xor_l(sq, o, L); skv += shfl_xor_l(skv, o, L); }
                  const float rq = 1.f / sqrtf(sq * (1.f / 384.f) + RMS_EPS), rkv = 1.f / sqrtf(skv * (1.f / 256.f) + RMS_EPS);
#define PK8(V) (u32x4){cvt_pk_bf16((V)[0], (V)[1]), cvt_pk_bf16((V)[2], (V)[3]), cvt_pk_bf16((V)[4], (V)[5]), cvt_pk_bf16((V)[6], (V)[7])}
                  { const f32x8 o = v0 * rq * g0; *(u32x4*)(cqn + (size_t)m * 384 + 8 * l) = PK8(o); }
                  { const f32x8 o = v1 * (l < 16 ? rq : rkv) * g1;
                    if (l < 16) *(u32x4*)(cqn + (size_t)m * 384 + 256 + 8 * l) = PK8(o); else *(u32x4*)(ckvn + (size_t)m * 256 + 8 * l - 128) = PK8(o); }
                  { const f32x8 o = v2 * rkv * g2; if (l < 16) *(u32x4*)(ckvn + (size_t)m * 256 + 128 + 8 * l) = PK8(o); }
#undef PK8
                  f32x8 pv;
#pragma unroll
                  for (int e = 0; e < 8; ++e) pv[e] = shfl_xor_l(v2[e], 4, L);
                  if (l >= 16 && l < 24) { const int d = 8 * (l - 16), dd = d & 31;
                      const f32x8 cc = *(const f32x8*)(ropeC + (size_t)m * 32 + dd), ss = *(const f32x8*)(ropeS + (size_t)m * 32 + dd);
                      const f32x8 o = (d < 32) ? (v2 * cc - pv * ss) : (pv * ss + v2 * cc);
                      *(u32x2*)((unsigned char*)kr + (size_t)m * 64 + d) = (u32x2){pk4_fp8((f32x4){o[0], o[1], o[2], o[3]}), pk4_fp8((f32x4){o[4], o[5], o[6], o[7]})}; } }
            }
            { PHASE_BEGIN();
              pg8::Gemm g{128, 128, 128u * 128u * 2u, 128u * 128u * 2u, 1, 128}; pg8::StaticOrder So; So.init(1, 512, F.G, bx, fst, 0, act + A_ZT, (size_t)256 * 128 * 2);
              pg8::EpiF1 E{(bf16_t*)(act + A_AP), tw}; pg8::gemm_phase(F.lds, g, So, E, F.tid); }
            GSYNC();
#ifdef PROBE_BUILD
            if (layer == 0) { { PHASE_BEGIN(); probe_a(F, a, ws, bx); } GSYNC(); }
#endif
            { PHASE_BEGIN();
              pg8::Gemm g{384, 384, 128u * 384u * 2u, 128u * 384u * 2u, 1, 384}; pg8::StaticOrder So; So.init(S / 256, 6, F.G, bx, act + A_CQN, (size_t)256 * 384 * 2, w + WE_Q, (size_t)256 * 384 * 2);
              pg8::EpiQ E{(unsigned char*)(act + A_Q), ropeC, ropeS}; pg8::gemm_phase(F.lds, g, So, E, F.tid); }
            { PHASE_BEGIN();
              pg8::Gemm g{256, 256, 128u * 256u * 2u, 128u * 256u * 2u, 1, 256}; pg8::StaticOrder So; So.init(S / 256, 4, F.G, bx, act + A_CKVN, (size_t)256 * 256 * 2, w + WE_KV, (size_t)256 * 256 * 2);
              pg8::EpiFp8 E{(unsigned char*)(act + A_K8), (size_t)1024}; pg8::gemm_phase(F.lds, g, So, E, F.tid); }
            { PHASE_BEGIN();
              pg8::Gemm g{256, 256, 128u * 256u * 2u, 128u * 256u * 2u, 1, 256}; pg8::StaticOrder So; So.init(4, S / 256, F.G, bx, w + WE_KV + (size_t)1024 * 256 * 2, (size_t)256 * 256 * 2, act + A_CKVN, (size_t)256 * 256 * 2);
              pg8::EpiFp8 E{(unsigned char*)(act + A_V8T), (size_t)S}; pg8::gemm_phase(F.lds, g, So, E, F.tid); }
            { PHASE_BEGIN();
              pg8::Gemm g{128, 128, 128u * 128u * 2u, 128u * 128u * 2u, 1, 128}; pg8::StaticOrder So; So.init(1, 512, F.G, bx, fst, 0, act + A_AP, (size_t)256 * 128 * 2);
              pg8::EpiF2 E{(bf16_t*)(ws + WS_MIX)}; pg8::gemm_phase(F.lds, g, So, E, F.tid); }
            GSYNC();
            { PHASE_BEGIN();
              const int h = bx & 7;
              for (int qb = bx >> 3; qb < 64; qb += (F.G >> 3))
                  att8::attn_unit(h, qb * 256, (const unsigned char*)(act + A_Q), (const unsigned char*)(act + A_K8), (const unsigned char*)(act + A_KR), (const unsigned char*)(act + A_V8T), (bf16_t*)(ws + WS_MIX), (char*)lds_raw, F.lds, F.tid); }
            GSYNC();
#ifdef PROBE_BUILD
            if (layer == 0) { { PHASE_BEGIN(); probe_b(F, a, ws, bx); } GSYNC(); }
#endif
            { PHASE_BEGIN();
              pg8::Gemm g{1536, 1536, 128u * 1536u * 2u, 128u * 1536u * 2u, 1, 1536}; pg8::StaticOrder So; So.init(S / 256, 4, F.G, bx, ws + WS_MIX, (size_t)256 * 1536 * 2, w + WE_OUTA, (size_t)256 * 1536 * 2);
              if constexpr (layer == 0) { pg8::EpiLn<false, true, true> E{nullptr, (_Float16*)(act + A_XHM), nullptr, inp(a, I_X), inp(a, I_MLG) + layer * DM, inp(a, I_MLB) + layer * DM, DN_ALPHA, (unsigned long long*)(ws + WS_LNX), (unsigned*)(ws + WS_LNCNT) + (layer * 2) * 4096};
                  pg8::gemm_phase(F.lds, g, So, E, F.tid); }
              else { pg8::EpiLn<false, true, false> E{(const _Float16*)xres, (_Float16*)(act + A_XHM), nullptr, nullptr, inp(a, I_MLG) + layer * DM, inp(a, I_MLB) + layer * DM, DN_ALPHA, (unsigned long long*)(ws + WS_LNX), (unsigned*)(ws + WS_LNCNT) + (layer * 2) * 4096};
                  pg8::gemm_phase(F.lds, g, So, E, F.tid); } }
            GSYNC();
        } else {
            { PHASE_BEGIN();
              pg8::Gemm g{DM, DM, 128u * DM * 2u, 128u * DM * 2u, 1, DM}; pg8::StaticOrder So; So.init(S / 256, 8, F.G, bx, xres, (size_t)256 * DM * 2, w + WO_IN, (size_t)256 * DM * 2);
              pg8::EpiBf16<1> E{(bf16_t*)(act + A_U), (size_t)2048}; pg8::gemm_phase<true>(F.lds, g, So, E, F.tid); }
            { PHASE_BEGIN();
              pg8::Gemm g{DM, DM, 128u * DM * 2u, 128u * DM * 2u, 1, DM}; pg8::StaticOrder So; So.init(8, S / 256, F.G, bx, w + WO_IN + (size_t)2048 * DM * 2, (size_t)256 * DM * 2, xres, (size_t)256 * DM * 2);
              pg8::EpiGeluColLn E{(bf16_t*)(act + A_VT), (size_t)S, inp(a, I_ONG) + li * 2048, inp(a, I_ONB) + li * 2048, (unsigned long long*)(ws + WS_CLNX), (unsigned*)(ws + WS_CLNCNT) + li * 4096, F.lds + 132096};
              pg8::gemm_phase<true>(F.lds, g, So, E, F.tid); }
            GSYNC();
#if 0
            { PHASE_BEGIN();
              bf16_t* vT = (bf16_t*)(act + A_VT); const float* ng = inp(a, I_ONG) + li * 2048; const float* nb = inp(a, I_ONB) + li * 2048;
              LAS float* psum = (LAS float*)F.lds; LAS float* psq = psum + 64 * 64; LAS float* stat = psq + 64 * 64;
              const int oct = F.tid & 7, strip = F.tid >> 3;
              for (int un = bx; un < S / 64; un += F.G) { const int s0 = un * 64 + oct * 8;
                  float sm[8], sq[8];
#pragma unroll
                  for (int e = 0; e < 8; ++e) { sm[e] = 0.f; sq[e] = 0.f; }
                  for (int i = 0; i < 32; ++i) { const int c = strip + 64 * i; const u32x4 r = *(const u32x4*)(vT + (size_t)c * S + s0);
#pragma unroll
                      for (int e = 0; e < 4; ++e) { const unsigned wv = r[e]; const float lo = __uint_as_float(wv << 16), hi = __uint_as_float(wv & 0xffff0000u);
                          sm[2 * e] += lo; sq[2 * e] += lo * lo; sm[2 * e + 1] += hi; sq[2 * e + 1] += hi * hi; } }
#pragma unroll
                  for (int e = 0; e < 8; ++e) { psum[strip * 64 + oct * 8 + e] = sm[e]; psq[strip * 64 + oct * 8 + e] = sq[e]; }
                  __syncthreads();
                  if (F.tid < 64) { float ts = 0.f, tq = 0.f; for (int k = 0; k < 64; ++k) { ts += psum[k * 64 + F.tid]; tq += psq[k * 64 + F.tid]; }
                      const float mean = ts * (1.f / 2048.f); const float var = fmaxf(tq * (1.f / 2048.f) - mean * mean, 0.f); stat[F.tid] = mean; stat[64 + F.tid] = 1.f / sqrtf(var + LN_EPS); }
                  __syncthreads();
                  float mu[8], rs[8];
#pragma unroll
                  for (int e = 0; e < 8; ++e) { mu[e] = stat[oct * 8 + e]; rs[e] = stat[64 + oct * 8 + e]; }
                  for (int i = 0; i < 32; ++i) { const int c = strip + 64 * i; u32x4* p = (u32x4*)(vT + (size_t)c * S + s0); const u32x4 r = *p; const float gg = ng[c], bb = nb[c];
                      u32x4 ov;
#pragma unroll
                      for (int e = 0; e < 4; ++e) { const unsigned wv = r[e]; const float lo = __uint_as_float(wv << 16), hi = __uint_as_float(wv & 0xffff0000u);
                          ov[e] = cvt_pk_bf16((lo - mu[2 * e]) * rs[2 * e] * gg + bb, (hi - mu[2 * e + 1]) * rs[2 * e + 1] * gg + bb); }
                      *p = ov; }
                  __syncthreads(); }
            }
            GSYNC();
#endif
            { PHASE_BEGIN();
              pg8::Gemm g{128, S, 128u * 128u * 2u, 256u * (unsigned)S * 2u, 1, 128}; pg8::SpatialOrder So{F.G, bx, (const char*)(w + WO_SP), (const char*)(act + A_VT), S};
              pg8::EpiSpatial E{(bf16_t*)(act + A_U), inp(a, I_OBSP) + li * 8 * 128}; pg8::gemm_phase(F.lds, g, So, E, F.tid); }
            GSYNC();
            { PHASE_BEGIN();
              pg8::Gemm g{2048, 2048, 128u * 2048u * 2u, 128u * 2048u * 2u, 1, 2048}; pg8::StaticOrder So; So.init(S / 256, 4, F.G, bx, act + A_U, (size_t)256 * 2048 * 2, w + WO_OUT, (size_t)256 * 2048 * 2);
              pg8::EpiLn<false, true> E{(const _Float16*)xres, (_Float16*)(act + A_XHM), nullptr, nullptr, inp(a, I_MLG) + layer * DM, inp(a, I_MLB) + layer * DM, DN_ALPHA, (unsigned long long*)(ws + WS_LNX), (unsigned*)(ws + WS_LNCNT) + (layer * 2) * 4096};
              pg8::gemm_phase(F.lds, g, So, E, F.tid); }
            GSYNC();
        }
        { PHASE_BEGIN();
          pg8::Gemm g{DM, DM, 128u * DM * 2u, 128u * DM * 2u, 1, DM}; pg8::StaticOrder So; So.init(S / 256, 22, F.G, bx, act + A_XHM, (size_t)256 * DM * 2, ws + WS_WFFN + WF_GU, (size_t)256 * DM * 2);
          pg8::EpiSwiglu E{(bf16_t*)(act + A_HMID), DFF}; pg8::gemm_phase<true>(F.lds, g, So, E, F.tid); }
        if (layer + 1 < 4) { PHASE_BEGIN();
            if (bx >= (F.G >> 1)) { F.gw = (bx - (F.G >> 1)) * NW + F.wave; F.NGW = (F.G >> 1) * NW;
                if (((layer + 1) & 1) == 0) { LAS float* tab = (LAS float*)(F.lds + 131072); if (F.tid < 256) tab[F.tid] = ((const float*)(ws + WS_FTAB))[F.tid]; __syncthreads(); convert_even(F, a, (layer + 1) >> 1); }
                else convert_odd(F, a, (layer + 1) >> 1);
                __syncthreads(); } }
        GSYNC();
        { PHASE_BEGIN();
          pg8::Gemm g{DFF, DFF, 128u * DFF * 2u, 128u * DFF * 2u, 1, DFF}; pg8::StaticOrder So; So.init(S / 256, 4, F.G, bx, act + A_HMID, (size_t)256 * DFF * 2, ws + WS_WFFN + WF_DN, (size_t)256 * DFF * 2);
          pg8::EpiLn<(layer == 3), (layer != 3)> E{(const _Float16*)(act + A_XHM), (_Float16*)xres, xres, nullptr, inp(a, I_FLG) + layer * DM, inp(a, I_FLB) + layer * DM, DN_ALPHA, (unsigned long long*)(ws + WS_LNX), (unsigned*)(ws + WS_LNCNT) + (layer * 2 + 1) * 4096};
          pg8::gemm_phase(F.lds, g, So, E, F.tid); }
        if (layer + 1 < 4) GSYNC();
}

__global__ void __launch_bounds__(512, 2) fwd_kernel(Args a) {
    extern __shared__ __attribute__((aligned(16))) unsigned char lds_raw[];
    cg::grid_group grid = cg::this_grid();
    { const int key = __builtin_amdgcn_s_getreg(0x2804) & 63; if ((threadIdx.x & 63) == 0) ((volatile LAS int*)((LAS unsigned char*)lds_raw + WAVE_TBL_OFF))[key] = threadIdx.x >> 6; }
    if (threadIdx.x == 0) { volatile LAS unsigned* st = (volatile LAS unsigned*)((LAS unsigned char*)lds_raw + XB_LDS_OFF); st[0] = 0u; st[1] = 0u; (void)xb_add(&((unsigned*)(a.ws + WS_BAR))[XB_XCNT(xb_xcc_id())], 1u); }
    __syncthreads();

    { PHASE_BEGIN();
      LAS float* tab = (LAS float*)(F.lds + 131072);
      if (F.tid < 128) { float s_, c_; sincos_rev((double)F.tid / 128.0, s_, c_); tab[F.tid] = c_ * 0.08838834764831845f; tab[128 + F.tid] = s_ * 0.08838834764831845f;
          if (bx == 0) { float* ft = (float*)(ws + WS_FTAB); ft[F.tid] = tab[F.tid]; ft[128 + F.tid] = tab[128 + F.tid]; } }
      __syncthreads();
      const int gt = bx * 512 + F.tid, NGT = F.G * 512;
      for (int e = gt; e < S * 32; e += NGT) { const int s = e >> 5, d = e & 31; const float ang = (float)s * ap_->inv_freq[d]; float s_, c_; sincos_rev((double)ang * 0.15915494309189533577, s_, c_); ropeC[e] = c_; ropeS[e] = s_; }
      for (int e = gt; e < 128 * 128; e += NGT) { const int ka = e >> 7, b = e & 127; float s_, c_; sincos_rev((double)(ka * b) / 16384.0, s_, c_); tw[e] = (f32x2){c_, s_}; }
      for (int e = gt; e < 256 * 128; e += NGT) { const int r = e >> 7, n = e & 127; const int idx = ((r & 127) * n) & 127; const float v = (r < 128) ? tab[idx] : tab[128 + idx]; fst[e] = (bf16_t)(cvt_pk_bf16(v, v) & 0xffffu); }
      const float* x = inp(a, I_X);
      for (size_t e = (size_t)gt * 8; e < (size_t)S * DM; e += (size_t)NGT * 8) { const f32x4 v = *(const f32x4*)(x + e), w2 = *(const f32x4*)(x + e + 4);
          const h16x4 h0 = __builtin_convertvector(v, h16x4), h1 = __builtin_convertvector(w2, h16x4); *(h16x8*)((_Float16*)xres + e) = __builtin_shufflevector(h0, h1, 0, 1, 2, 3, 4, 5, 6, 7); }
      convert_even(F, a, 0); convert_ffn(F, a, 0);
#ifdef PROBE_BUILD
      if (bx == 0 && F.tid == 0) *(unsigned*)ws = 0u;
#endif
    }
    if (a.grid < 0) grid.sync();
    GSYNC();

    layer_body<0>(a, lds_raw, grid); layer_body<1>(a, lds_raw, grid); layer_body<2>(a, lds_raw, grid); layer_body<3>(a, lds_raw, grid);
#ifdef PROBE_BUILD
    grid.sync();
    { PHASE_BEGIN(); const unsigned m = *(volatile unsigned*)ws; if (m) { const float dl = 1.0f + (float)m; for (size_t e = (size_t)bx * 512 + F.tid; e < (size_t)S * DM; e += (size_t)F.G * 512) xres[e] += dl; } }
#endif
}

extern "C" void kernel_launch(void* const* d_in, const int* in_sizes, int n_in, void* d_out, int out_size, void* d_ws, size_t ws_size, hipStream_t stream) {
    static int grid = 0;
    if (grid == 0) {
        if (n_in != 21 || out_size != S * DM || ws_size < WS_END) { fprintf(stderr, "kernel_launch: unexpected shapes (n_in %d out %d ws %zu)\n", n_in, out_size, ws_size); grid = -1; return; }
        int dev = 0, cus = 0, per_cu = 0;
        hipGetDevice(&dev); hipDeviceGetAttribute(&cus, hipDeviceAttributeMultiprocessorCount, dev);
        if (hipFuncSetAttribute((const void*)fwd_kernel, hipFuncAttributeMaxDynamicSharedMemorySize, LDS_BYTES) != hipSuccess) { fprintf(stderr, "kernel_launch: hipFuncSetAttribute failed\n"); grid = -1; return; }
        if (hipOccupancyMaxActiveBlocksPerMultiprocessor(&per_cu, (const void*)fwd_kernel, 512, LDS_BYTES) != hipSuccess || per_cu < 1) per_cu = 1;
        (void)hipGetLastError();
        grid = cus * per_cu; grid &= ~7; if (grid <= 0) grid = 8;
    }
    if (grid < 0) return;
    if (hipMemsetAsync(d_ws, 0, 262144, stream) != hipSuccess) { fprintf(stderr, "kernel_launch: memset failed\n"); return; }
    Args a{};
    for (int i = 0; i < 21; ++i) a.in[i] = (const float*)d_in[i];
    a.out = (float*)d_out; a.ws = (unsigned char*)d_ws; a.grid = grid; a.pad = 0;
    for (int d = 0; d < 32; ++d) { const float p = (float)std::pow(10000.0, (double)d / 32.0); a.inv_freq[d] = 1.0f / p; }
    void* args[] = {&a};
    hipError_t e = hipLaunchCooperativeKernel((const void*)fwd_kernel, dim3(grid), dim3(512), args, LDS_BYTES, stream);
    if (e != hipSuccess) fprintf(stderr, "cooperative launch failed: %s (grid %d)\n", hipGetErrorString(e), grid);
}
```

```cpp
#include <hip/hip_runtime.h>
#include <hip/hip_cooperative_groups.h>
#include <cstdio>
#include <cstdint>
#include <cmath>
namespace cg = cooperative_groups;

#define LAS __attribute__((address_space(3)))
typedef unsigned short bf16_t;
typedef short bf16x8 __attribute__((ext_vector_type(8)));
typedef short s16x4 __attribute__((ext_vector_type(4)));
typedef float f32x4 __attribute__((ext_vector_type(4)));
typedef float f32x2 __attribute__((ext_vector_type(2)));
typedef float f32x16 __attribute__((ext_vector_type(16)));
typedef unsigned u32x4 __attribute__((ext_vector_type(4)));
typedef unsigned u32x2 __attribute__((ext_vector_type(2)));
typedef _Float16 h16x4 __attribute__((ext_vector_type(4)));
typedef int v8i __attribute__((ext_vector_type(8)));
typedef _Float16 h16x2 __attribute__((ext_vector_type(2)));
typedef _Float16 h16x8 __attribute__((ext_vector_type(8)));

constexpr int S = 16384, DM = 1024, DFF = 2816;
constexpr float DN_ALPHA = 1.6817928305074290f;
constexpr float LN_EPS = 1e-5f, RMS_EPS = 1e-6f;
constexpr int NW = 8;

constexpr size_t MiB = 1u << 20;
constexpr size_t WS_FTAB = 7 * MiB, WS_ROPEC = 1 * MiB, WS_ROPES = 3 * MiB, WS_TW = 5 * MiB, WS_FST = 5 * MiB + 256 * 1024;
constexpr size_t WS_WMIX = 8 * MiB, WS_WFFN = 24 * MiB, WS_XB = 42 * MiB, WS_ACT = 74 * MiB;
constexpr size_t WE_INN = 0, WE_INF = (3 * MiB) / 2, WE_Q = (7 * MiB) / 2, WE_KV = 5 * MiB, WE_OUTA = 6 * MiB, WE_OUTF = 8 * MiB;
constexpr size_t WO_IN = 0, WO_SP = 8 * MiB, WO_OUT = 9 * MiB;
constexpr size_t WF_GU = 0, WF_DN = 11 * MiB;
constexpr size_t A_Q = 24 * MiB, A_HBUF = 0, A_KV = 48 * MiB, A_ZT = 80 * MiB, A_KR = 112 * MiB, A_AP = 114 * MiB, A_ATTNO = 114 * MiB,
                 A_CQN = 146 * MiB, A_CKVN = 158 * MiB, A_MIXF = 166 * MiB, A_HMID = 0, A_U = 0, A_VT = 64 * MiB, A_K8 = 48 * MiB, A_V8T = 64 * MiB, A_XHM = 146 * MiB;
constexpr size_t WS_END = 256 * MiB;
constexpr size_t WS_MIX = WS_XB;

__device__ __forceinline__ unsigned cvt_pk_bf16(float lo, float hi) { unsigned r; asm volatile("v_cvt_pk_bf16_f32 %0, %1, %2" : "=v"(r) : "v"(lo), "v"(hi)); return r; }
__device__ __forceinline__ unsigned cvt_pk_f16(float lo, float hi) { const h16x2 v = {(_Float16)lo, (_Float16)hi}; return __builtin_bit_cast(unsigned, v); }
__device__ __forceinline__ unsigned pk4_fp8(f32x4 v) { int x = __builtin_amdgcn_cvt_pk_fp8_f32(v[0], v[1], 0, false); x = __builtin_amdgcn_cvt_pk_fp8_f32(v[2], v[3], x, true); return (unsigned)x; }
__device__ __forceinline__ float bf2f(unsigned short h) { return __uint_as_float(((unsigned)h) << 16); }
__device__ __forceinline__ float shfl_xor_l(float v, int o, int lane) { return __int_as_float(__builtin_amdgcn_ds_bpermute((lane ^ o) << 2, __float_as_int(v))); }
__device__ __forceinline__ float wave_sum(float v, int lane) {
#pragma unroll
    for (int o = 1; o < 64; o <<= 1) v += shfl_xor_l(v, o, lane);
    return v;
}
__device__ __forceinline__ f32x2 gelu_pk(f32x2 v) {
    const f32x2 av = __builtin_elementwise_abs(v), d = av * 0.2316418882f + 1.0f;
    f32x2 t; t.x = __builtin_amdgcn_rcpf(d.x); t.y = __builtin_amdgcn_rcpf(d.y);
    f32x2 q = t * 0.5307027145f + (-0.7265760135f); q = q * t + 0.7107068705f; q = q * t + (-0.142248368f); q = q * t + 0.127414796f; q = q * t;
    const f32x2 s = (v * v) * (-0.72134752044f);
    f32x2 e; e.x = __builtin_amdgcn_exp2f(s.x); e.y = __builtin_amdgcn_exp2f(s.y);
    const f32x2 m = v * (q * e), r = v - m;
    f32x2 o; o.x = v.x < 0.f ? m.x : r.x; o.y = v.y < 0.f ? m.y : r.y; return o;
}
__device__ __forceinline__ float silu_f(float g) { return g * __builtin_amdgcn_rcpf(1.0f + __builtin_amdgcn_exp2f(-1.4426950408889634f * g)); }

__device__ __forceinline__ int launder_i(int v) { asm volatile("" : "+v"(v)); return __builtin_amdgcn_readfirstlane(v); }
template <class T> __device__ __forceinline__ T* launder_p(T* p) { unsigned lo = (unsigned)(uintptr_t)p, hi = (unsigned)((uintptr_t)p >> 32); asm volatile("" : "+v"(lo), "+v"(hi));
    lo = __builtin_amdgcn_readfirstlane(lo); hi = __builtin_amdgcn_readfirstlane(hi); return (T*)(((uintptr_t)hi << 32) | (uintptr_t)lo); }

constexpr int WAVE_TBL_OFF = 147456 - 256;
__device__ __forceinline__ int hw_lane() { int l; asm volatile("v_mbcnt_lo_u32_b32 %0, -1, 0\n\tv_mbcnt_hi_u32_b32 %0, -1, %0" : "=v"(l)); return l; }
__device__ __forceinline__ int hw_wave(LAS unsigned char* lds) { const int key = __builtin_amdgcn_s_getreg(0x2804) & 63; const int w = ((volatile LAS int*)(lds + WAVE_TBL_OFF))[key]; return __builtin_amdgcn_readfirstlane(w); }
__device__ __forceinline__ float zero_f() { float z = 0.f; asm volatile("" : "+v"(z)); return z; }
__device__ __forceinline__ void sincos_rev(double rev, float& s, float& c) {
    const double r = rev - rint(rev);
    const double q = rint(4.0 * r);
    const double t = r - 0.25 * q;
    const double a = t * 6.283185307179586476925, a2 = a * a;
    const double sn = a * (1.0 + a2 * (-1.0 / 6 + a2 * (1.0 / 120 + a2 * (-1.0 / 5040 + a2 * (1.0 / 362880 + a2 * (-1.0 / 39916800))))));
    const double cs = 1.0 + a2 * (-0.5 + a2 * (1.0 / 24 + a2 * (-1.0 / 720 + a2 * (1.0 / 40320 + a2 * (-1.0 / 3628800 + a2 * (1.0 / 479001600))))));
    const int qi = ((int)q) & 3;
    double S_, C_;
    if (qi == 0) { S_ = sn; C_ = cs; } else if (qi == 1) { S_ = cs; C_ = -sn; } else if (qi == 2) { S_ = -sn; C_ = -cs; } else { S_ = -cs; C_ = sn; }
    s = (float)S_; c = (float)C_;
}

namespace pg8 {
constexpr int BM = 256, BK = 64, HALF = 128, HTB = HALF * BK * 2, STAGE_BYTES = 8 * HTB, NXCD = 8, WGM = 8;
__device__ __forceinline__ int lds_byte(int r, int c) { const int st = (r >> 4) * 2 + (c >> 5), rr = r & 15, cc = c & 31, ob = rr * 64 + cc * 2; return st * 1024 + (ob ^ (((ob >> 9) & 1) << 5)); }
__device__ __forceinline__ void stage_rc(int b, int& R, int& C) { const int st = b / 1024, sb = b % 1024, swz = sb ^ (((sb >> 9) & 1) << 5); R = (st >> 1) * 16 + swz / 64; C = (st & 1) * 32 + (swz % 64) / 2; }
__device__ __forceinline__ int perm32(int rho) { const int n = rho >> 4, i = rho & 15; return 8 * (i >> 2) + 4 * n + (i & 3); }

struct Unit { int pm, pn; const char* a; const char* b; };
struct Gemm { int lda, ldb; unsigned hstepA, hstepB; int bmul; int K; };

struct StaticOrder {
    int nM, nN, nwg, G, c; const char* A; const char* B; size_t tsA, tsB;
    __device__ void init(int nM_, int nN_, int G_, int c_, const void* A_, size_t tsA_, const void* B_, size_t tsB_) { nM = nM_; nN = nN_; nwg = nM * nN; G = G_; c = c_; A = (const char*)A_; B = (const char*)B_; tsA = tsA_; tsB = tsB_; }
    __device__ bool next(int i, Unit& u) const {
        const long L = (long)i * G + c; if (L >= nwg) return false;
        int wgid = (int)L; { const int q = nwg / NXCD, r = nwg % NXCD, xcd = wgid % NXCD, off = wgid / NXCD; wgid = (xcd < r ? xcd * (q + 1) : r * (q + 1) + (xcd - r) * q) + off; }
        const int nig = WGM * nN, gid = wgid / nig, fm = gid * WGM, gsz = (nM - fm) < WGM ? (nM - fm) : WGM;
        u.pm = fm + ((wgid % nig) % gsz); u.pn = (wgid % nig) / gsz; u.a = launder_p(A + (size_t)u.pm * tsA); u.b = launder_p(B + (size_t)u.pn * tsB); return true;
    }
};
struct SpatialOrder {
    int G, c; const char* A; const char* B; int ldb;
    __device__ bool next(int i, Unit& u) const {
        const int L = i * G + c; if (L >= 1024) return false;
        u.pm = L & 3; u.pn = L >> 2; const int h = u.pn & 1, ch = u.pn >> 1;
        u.a = launder_p(A + (size_t)u.pm * 256 * 128 * 2); u.b = launder_p(B + ((size_t)(512 * u.pm + 128 * h) * ldb + (size_t)ch * 128) * 2); return true;
    }
};

typedef f32x4 Acc[2][2][4][2];

__device__ __forceinline__ u32x4 pack8(f32x4 v0, f32x4 v1) { u32x4 w; w.x = cvt_pk_bf16(v0[0], v0[1]); w.y = cvt_pk_bf16(v0[2], v0[3]); w.z = cvt_pk_bf16(v1[0], v1[1]); w.w = cvt_pk_bf16(v1[2], v1[3]); return w; }

struct EpiF32 { static constexpr bool PERM = false, AFTER_DRAIN = false; float* O; int ldc;
    __device__ __forceinline__ void operator()(const Acc& acc, const Unit& u, int wr, int wc, int fr, int fq) const {
#pragma unroll
        for (int ai = 0; ai < 2; ++ai)
#pragma unroll
            for (int m = 0; m < 4; ++m) { float* rowp = O + (size_t)(u.pm * BM + ai * HALF + wr * 64 + m * 16 + fr) * ldc + u.pn * BM + wc * 32 + 4 * fq;
#pragma unroll
                for (int bj = 0; bj < 2; ++bj)
#pragma unroll
                    for (int n = 0; n < 2; ++n) *(f32x4*)(rowp + bj * HALF + n * 16) = acc[ai][bj][m][n]; }
    }
};
struct EpiF16 { static constexpr bool PERM = true, AFTER_DRAIN = false; _Float16* O; int ldc;
    __device__ __forceinline__ void operator()(const Acc& acc, const Unit& u, int wr, int wc, int fr, int fq) const {
#pragma unroll
        for (int ai = 0; ai < 2; ++ai)
#pragma unroll
            for (int m = 0; m < 4; ++m) { _Float16* rowp = O + (size_t)(u.pm * BM + ai * HALF + wr * 64 + m * 16 + fr) * ldc + u.pn * BM + wc * 32 + 8 * fq;
#pragma unroll
                for (int bj = 0; bj < 2; ++bj) { const h16x4 h0 = __builtin_convertvector(acc[ai][bj][m][0], h16x4), h1 = __builtin_convertvector(acc[ai][bj][m][1], h16x4);
                    *(h16x8*)(rowp + bj * HALF) = __builtin_shufflevector(h0, h1, 0, 1, 2, 3, 4, 5, 6, 7); } }
    }
};
struct EpiResid { static constexpr bool PERM = false, AFTER_DRAIN = false; float* O; int ldc; float alpha;
    __device__ __forceinline__ void operator()(const Acc& acc, const Unit& u, int wr, int wc, int fr, int fq) const {
#pragma unroll
        for (int ai = 0; ai < 2; ++ai)
#pragma unroll
            for (int m = 0; m < 4; ++m) { float* rowp = O + (size_t)(u.pm * BM + ai * HALF + wr * 64 + m * 16 + fr) * ldc + u.pn * BM + wc * 32 + 4 * fq;
#pragma unroll
                for (int bj = 0; bj < 2; ++bj)
#pragma unroll
                    for (int n = 0; n < 2; ++n) { f32x4* p = (f32x4*)(rowp + bj * HALF + n * 16); const f32x4 o = *p; *p = o * alpha + acc[ai][bj][m][n]; } }
    }
};
template <bool SRC_F32> struct EpiResidH { static constexpr bool PERM = false, AFTER_DRAIN = false; _Float16* Ho; const float* Xs; const _Float16* Hs; int ldc; float alpha;
    __device__ __forceinline__ void operator()(const Acc& acc, const Unit& u, int wr, int wc, int fr, int fq) const {
#pragma unroll
        for (int ai = 0; ai < 2; ++ai)
#pragma unroll
            for (int m = 0; m < 4; ++m) { const size_t roff = (size_t)(u.pm * BM + ai * HALF + wr * 64 + m * 16 + fr) * ldc + u.pn * BM + wc * 32 + 4 * fq;
#pragma unroll
                for (int bj = 0; bj < 2; ++bj)
#pragma unroll
                    for (int n = 0; n < 2; ++n) { f32x4 xv; if constexpr (SRC_F32) xv = *(const f32x4*)(Xs + roff + bj * HALF + n * 16); else xv = __builtin_convertvector(*(const h16x4*)(Hs + roff + bj * HALF + n * 16), f32x4);
                        *(h16x4*)(Ho + roff + bj * HALF + n * 16) = __builtin_convertvector(xv * alpha + acc[ai][bj][m][n], h16x4); } }
    }
};
template <int ACT> struct EpiBf16 { static constexpr bool PERM = true, AFTER_DRAIN = false; bf16_t* O; size_t ldc;
    __device__ __forceinline__ void operator()(const Acc& acc, const Unit& u, int wr, int wc, int fr, int fq) const {
#pragma unroll
        for (int ai = 0; ai < 2; ++ai)
#pragma unroll
            for (int m = 0; m < 4; ++m) { bf16_t* rowp = O + (size_t)(u.pm * BM + ai * HALF + wr * 64 + m * 16 + fr) * ldc + u.pn * BM + wc * 32 + 8 * fq;
#pragma unroll
                for (int bj = 0; bj < 2; ++bj) { f32x4 v0 = acc[ai][bj][m][0], v1 = acc[ai][bj][m][1];
                    if (ACT == 1) { f32x2 a = gelu_pk((f32x2){v0[0], v0[1]}), b = gelu_pk((f32x2){v0[2], v0[3]}), c = gelu_pk((f32x2){v1[0], v1[1]}), d = gelu_pk((f32x2){v1[2], v1[3]});
                        v0 = (f32x4){a.x, a.y, b.x, b.y}; v1 = (f32x4){c.x, c.y, d.x, d.y}; }
                    *(u32x4*)(rowp + bj * HALF) = pack8(v0, v1); } }
    }
};
struct EpiGeluColLn { static constexpr bool PERM = true, AFTER_DRAIN = false;
    bf16_t* O; size_t ldc; const float* g; const float* b; unsigned long long* xbuf; unsigned* cnt; LAS unsigned char* sl;
    __device__ __forceinline__ void operator()(Acc& acc, const Unit& u, int wr, int wc, int fr, int fq) const {
        const int lane = fq * 16 + fr, wid = wr * 4 + wc, tid = wid * 64 + lane;
        LAS f32x2* P = (LAS f32x2*)sl; LAS f32x2* Sx = (LAS f32x2*)(sl + 4096);
        f32x4 cs[2][2], cq[2][2];
#pragma unroll
        for (int bj = 0; bj < 2; ++bj)
#pragma unroll
            for (int n = 0; n < 2; ++n) { cs[bj][n] = (f32x4){0.f, 0.f, 0.f, 0.f}; cq[bj][n] = (f32x4){0.f, 0.f, 0.f, 0.f}; }
#pragma unroll
        for (int ai = 0; ai < 2; ++ai)
#pragma unroll
            for (int m = 0; m < 4; ++m)
#pragma unroll
                for (int bj = 0; bj < 2; ++bj)
#pragma unroll
                    for (int n = 0; n < 2; ++n) { const f32x4 v = acc[ai][bj][m][n]; const f32x2 a = gelu_pk((f32x2){v[0], v[1]}), c = gelu_pk((f32x2){v[2], v[3]});
                        const f32x4 gv = {a.x, a.y, c.x, c.y}; acc[ai][bj][m][n] = gv; cs[bj][n] += gv; cq[bj][n] += gv * gv; }
#pragma unroll
        for (int bj = 0; bj < 2; ++bj)
#pragma unroll
            for (int n = 0; n < 2; ++n)
#pragma unroll
                for (int j = 0; j < 4; ++j) { float s = cs[bj][n][j], q = cq[bj][n][j];
#pragma unroll
                    for (int o = 1; o < 16; o <<= 1) { s += shfl_xor_l(s, o, lane); q += shfl_xor_l(q, o, lane); }
                    if (fr == 0) P[wr * 256 + bj * HALF + wc * 32 + 8 * fq + 4 * n + j] = (f32x2){s, q}; }
        asm volatile("s_waitcnt lgkmcnt(0)" ::: "memory"); __builtin_amdgcn_s_barrier(); asm volatile("" ::: "memory");
        if (tid < 256) { const f32x2 a = P[tid], c = P[256 + tid];
            __hip_atomic_store(xbuf + ((size_t)u.pn * 256 + tid) * 8 + u.pm, ((unsigned long long)__float_as_uint(a.y + c.y) << 32) | __float_as_uint(a.x + c.x), __ATOMIC_RELAXED, __HIP_MEMORY_SCOPE_AGENT); }
        asm volatile("s_waitcnt vmcnt(0)" ::: "memory");
        if (lane == 0) __hip_atomic_fetch_add(cnt + 64 * u.pn, 1u, __ATOMIC_RELAXED, __HIP_MEMORY_SCOPE_AGENT);
        if (wid == 0) { unsigned sp = 0;
            while ((unsigned)__builtin_amdgcn_readfirstlane(__hip_atomic_load(cnt + 64 * u.pn, __ATOMIC_RELAXED, __HIP_MEMORY_SCOPE_AGENT)) < 64u) { __builtin_amdgcn_s_sleep(2); if (++sp > (1u << 22)) break; }
            __builtin_amdgcn_fence(__ATOMIC_ACQUIRE, "agent"); }
        asm volatile("s_waitcnt vmcnt(0) lgkmcnt(0)" ::: "memory"); __builtin_amdgcn_s_barrier(); asm volatile("" ::: "memory");
        if (tid < 256) { const unsigned long long* slot = xbuf + ((size_t)u.pn * 256 + tid) * 8; float ts = 0.f, tq = 0.f;
#pragma unroll
            for (int t = 0; t < 8; ++t) { const unsigned long long w = __hip_atomic_load(slot + t, __ATOMIC_RELAXED, __HIP_MEMORY_SCOPE_AGENT); ts += __uint_as_float((unsigned)w); tq += __uint_as_float((unsigned)(w >> 32)); }
            const float mean = ts * (1.f / 2048.f); const float var = fmaxf(tq * (1.f / 2048.f) - mean * mean, 0.f); Sx[tid] = (f32x2){mean, 1.f / sqrtf(var + LN_EPS)}; }
        asm volatile("s_waitcnt lgkmcnt(0)" ::: "memory"); __builtin_amdgcn_s_barrier(); asm volatile("" ::: "memory");
#pragma unroll
        for (int bj = 0; bj < 2; ++bj) { f32x4 mu[2], rs[2];
#pragma unroll
            for (int n = 0; n < 2; ++n)
#pragma unroll
                for (int j = 0; j < 4; ++j) { const f32x2 s = Sx[bj * HALF + wc * 32 + 8 * fq + 4 * n + j]; mu[n][j] = s.x; rs[n][j] = s.y; }
#pragma unroll
            for (int ai = 0; ai < 2; ++ai)
#pragma unroll
                for (int m = 0; m < 4; ++m) { const int ch = u.pm * BM + ai * HALF + wr * 64 + m * 16 + fr; const float gg = g[ch], bb = b[ch];
                    const f32x4 v0 = (acc[ai][bj][m][0] - mu[0]) * rs[0] * gg + bb, v1 = (acc[ai][bj][m][1] - mu[1]) * rs[1] * gg + bb;
                    *(u32x4*)(O + (size_t)ch * ldc + u.pn * BM + bj * HALF + wc * 32 + 8 * fq) = pack8(v0, v1); } }
        asm volatile("s_waitcnt lgkmcnt(0)" ::: "memory"); __builtin_amdgcn_s_barrier(); asm volatile("" ::: "memory");
    }
};
struct EpiSwiglu { static constexpr bool PERM = true, AFTER_DRAIN = false; bf16_t* O; int ldc;
    __device__ __forceinline__ void operator()(const Acc& acc, const Unit& u, int wr, int wc, int fr, int fq) const {
#pragma unroll
        for (int ai = 0; ai < 2; ++ai)
#pragma unroll
            for (int m = 0; m < 4; ++m) { bf16_t* rowp = O + (size_t)(u.pm * BM + ai * HALF + wr * 64 + m * 16 + fr) * ldc + u.pn * HALF + wc * 32 + 8 * fq;
                f32x4 v0, v1;
#pragma unroll
                for (int j = 0; j < 4; ++j) { v0[j] = silu_f(acc[ai][0][m][0][j]) * acc[ai][1][m][0][j]; v1[j] = silu_f(acc[ai][0][m][1][j]) * acc[ai][1][m][1][j]; }
                *(u32x4*)rowp = pack8(v0, v1); }
    }
};
constexpr float QSC = 0.07216878364870323f * 1.4426950408889634f;
struct EpiQ { static constexpr bool PERM = true, AFTER_DRAIN = false; unsigned char* Q; const float* rc; const float* rs;
    __device__ __forceinline__ void operator()(const Acc& acc, const Unit& u, int wr, int wc, int fr, int fq) const {
#pragma unroll
        for (int ai = 0; ai < 2; ++ai)
#pragma unroll
            for (int m = 0; m < 4; ++m) { const int row = u.pm * BM + ai * HALF + wr * 64 + m * 16 + fr;
                if (u.pn < 4) {
#pragma unroll
                    for (int bj = 0; bj < 2; ++bj) { const int head = 2 * u.pn + bj;
                        *(u32x2*)(Q + ((size_t)head * S + row) * 192 + wc * 32 + 8 * fq) = (u32x2){pk4_fp8(acc[ai][bj][m][0] * QSC), pk4_fp8(acc[ai][bj][m][1] * QSC)}; }
                } else { const int head = 4 * (u.pn - 4) + wc; const int d0 = 8 * fq;
                    const f32x4 c0 = *(const f32x4*)(rc + (size_t)row * 32 + d0), c1 = *(const f32x4*)(rc + (size_t)row * 32 + d0 + 4);
                    const f32x4 s0 = *(const f32x4*)(rs + (size_t)row * 32 + d0), s1 = *(const f32x4*)(rs + (size_t)row * 32 + d0 + 4);
                    const f32x4 a0 = acc[ai][0][m][0] * QSC, a1 = acc[ai][0][m][1] * QSC, b0 = acc[ai][1][m][0] * QSC, b1 = acc[ai][1][m][1] * QSC;
                    unsigned char* qp = Q + ((size_t)head * S + row) * 192 + 128 + d0;
                    *(u32x2*)qp = (u32x2){pk4_fp8(a0 * c0 - b0 * s0), pk4_fp8(a1 * c1 - b1 * s1)};
                    *(u32x2*)(qp + 32) = (u32x2){pk4_fp8(a0 * s0 + b0 * c0), pk4_fp8(a1 * s1 + b1 * c1)}; }
            }
    }
};
struct EpiFp8 { static constexpr bool PERM = true, AFTER_DRAIN = false; unsigned char* O; size_t ldc;
    __device__ __forceinline__ void operator()(const Acc& acc, const Unit& u, int wr, int wc, int fr, int fq) const {
#pragma unroll
        for (int ai = 0; ai < 2; ++ai)
#pragma unroll
            for (int m = 0; m < 4; ++m) { unsigned char* rowp = O + (size_t)(u.pm * BM + ai * HALF + wr * 64 + m * 16 + fr) * ldc + u.pn * BM + wc * 32 + 8 * fq;
#pragma unroll
                for (int bj = 0; bj < 2; ++bj) *(u32x2*)(rowp + bj * HALF) = (u32x2){pk4_fp8(acc[ai][bj][m][0]), pk4_fp8(acc[ai][bj][m][1])}; }
    }
};
struct EpiF1 { static constexpr bool PERM = true, AFTER_DRAIN = false; bf16_t* AP; const f32x2* tw;
    __device__ __forceinline__ void operator()(const Acc& acc, const Unit& u, int wr, int wc, int fr, int fq) const {
        const int g = u.pn >> 7, ch = u.pn & 127, b0 = wc * 32 + 8 * fq;
#pragma unroll
        for (int m = 0; m < 4; ++m) { const int ka = wr * 64 + m * 16 + fr;
            f32x4 orr[2], oi[2];
#pragma unroll
            for (int n = 0; n < 2; ++n) { const f32x4 c1r = acc[0][0][m][n] - acc[1][1][m][n], c1i = -(acc[0][1][m][n] + acc[1][0][m][n]);
#pragma unroll
                for (int j = 0; j < 4; ++j) { const f32x2 t = tw[ka * 128 + b0 + 4 * n + j];
                    orr[n][j] = c1r[j] * t.x + c1i[j] * t.y; oi[n][j] = c1i[j] * t.x - c1r[j] * t.y; } }
            bf16_t* p = AP + ((((size_t)ka * 4 + g) * 2) * 128 + ch) * 128 + b0;
            *(u32x4*)p = pack8(orr[0], orr[1]); *(u32x4*)(p + 128 * 128) = pack8(oi[0], oi[1]); }
    }
};
struct EpiF2 { static constexpr bool PERM = true, AFTER_DRAIN = false; bf16_t* MF;
    __device__ __forceinline__ void operator()(const Acc& acc, const Unit& u, int wr, int wc, int fr, int fq) const {
        const int ka = u.pn >> 2, g = u.pn & 3;
#pragma unroll
        for (int m = 0; m < 4; ++m) { const int kb = wr * 64 + m * 16 + fr;
            *(u32x4*)(MF + (size_t)(ka + 128 * kb) * 1536 + 1024 + g * 128 + wc * 32 + 8 * fq) = pack8(acc[0][0][m][0] + acc[1][1][m][0], acc[0][0][m][1] + acc[1][1][m][1]); }
    }
};
struct EpiSpatial { static constexpr bool PERM = true, AFTER_DRAIN = false; bf16_t* U; const float* bs;
    __device__ __forceinline__ void operator()(const Acc& acc, const Unit& u, int wr, int wc, int fr, int fq) const {
        const int h = u.pn & 1, chunk = u.pn >> 1;
#pragma unroll
        for (int t = 0; t < 2; ++t) { const int g = 2 * u.pm + t;
#pragma unroll
            for (int m = 0; m < 4; ++m) { const int p = wr * 64 + m * 16 + fr; const float b = bs[g * 128 + p];
                bf16_t* up = U + (size_t)(chunk * 128 + p) * 2048 + g * 256 + h * 128 + wc * 32 + 8 * fq;
                const u32x4 uv = *(const u32x4*)up; f32x4 v0, v1;
                v0[0] = __uint_as_float(uv.x << 16); v0[1] = __uint_as_float(uv.x & 0xffff0000u); v0[2] = __uint_as_float(uv.y << 16); v0[3] = __uint_as_float(uv.y & 0xffff0000u);
                v1[0] = __uint_as_float(uv.z << 16); v1[1] = __uint_as_float(uv.z & 0xffff0000u); v1[2] = __uint_as_float(uv.w << 16); v1[3] = __uint_as_float(uv.w & 0xffff0000u);
                *(u32x4*)up = pack8(v0 * (acc[t][t][m][0] + b), v1 * (acc[t][t][m][1] + b)); } }
    }
};


template <bool WRITE_F32, bool WRITE_F16, bool SRC_F32 = false> struct EpiLn { static constexpr bool PERM = true, AFTER_DRAIN = true;
    const _Float16* Hs; _Float16* Ho; float* X; const float* Xs; const float* g; const float* b; float alpha; unsigned long long* xbuf; unsigned* cnt;
    __device__ __forceinline__ void fused(Acc& acc, const Unit& u, int wr, int wc, int fr, int fq, LAS unsigned char* lds, int wid, int lane) const {
        const int col0 = u.pn * BM + wc * 32 + 8 * fq;
#pragma unroll
        for (int ai = 0; ai < 2; ++ai)
#pragma unroll
            for (int m = 0; m < 4; ++m) { const size_t roff = (size_t)(u.pm * BM + ai * HALF + wr * 64 + m * 16 + fr) * DM + col0;
#pragma unroll
                for (int bj = 0; bj < 2; ++bj) {
                    if constexpr (SRC_F32) { acc[ai][bj][m][0] += *(const f32x4*)(Xs + roff + bj * HALF) * alpha; acc[ai][bj][m][1] += *(const f32x4*)(Xs + roff + bj * HALF + 4) * alpha; }
                    else { const h16x8 hv = *(const h16x8*)(Hs + roff + bj * HALF);
                        acc[ai][bj][m][0] += __builtin_convertvector(__builtin_shufflevector(hv, hv, 0, 1, 2, 3), f32x4) * alpha;
                        acc[ai][bj][m][1] += __builtin_convertvector(__builtin_shufflevector(hv, hv, 4, 5, 6, 7), f32x4) * alpha; } }
                asm volatile("" ::: "memory"); }
        LAS f32x2* P = (LAS f32x2*)lds; LAS f32x2* Sx = (LAS f32x2*)(lds + 8192);
#pragma unroll
        for (int ai = 0; ai < 2; ++ai)
#pragma unroll
            for (int m = 0; m < 4; ++m) { float s = 0.f;
#pragma unroll
                for (int bj = 0; bj < 2; ++bj)
#pragma unroll
                    for (int n = 0; n < 2; ++n) { const f32x4 x = acc[ai][bj][m][n]; s += (x[0] + x[1]) + (x[2] + x[3]); }
                s += shfl_xor_l(s, 16, lane); s += shfl_xor_l(s, 32, lane);
                const float mw = s * (1.0f / 64.0f); float q = 0.f;
#pragma unroll
                for (int bj = 0; bj < 2; ++bj)
#pragma unroll
                    for (int n = 0; n < 2; ++n) { const f32x4 d = acc[ai][bj][m][n] - mw; q += (d[0] * d[0] + d[1] * d[1]) + (d[2] * d[2] + d[3] * d[3]); }
                q += shfl_xor_l(q, 16, lane); q += shfl_xor_l(q, 32, lane);
                if (fq == 0) P[(ai * HALF + wr * 64 + m * 16 + fr) * 4 + wc] = (f32x2){mw, q}; }
        asm volatile("s_waitcnt lgkmcnt(0)" ::: "memory"); __builtin_amdgcn_s_barrier(); asm volatile("" ::: "memory");
        const int row = wid * 32 + (lane & 31);
        if (lane < 32) { const f32x2 a = P[row * 4 + 0], b2 = P[row * 4 + 1], c = P[row * 4 + 2], d = P[row * 4 + 3];
            const float mt = (a.x + b2.x + c.x + d.x) * 0.25f; const float da = a.x - mt, db = b2.x - mt, dc = c.x - mt, dd = d.x - mt;
            const float m2 = (a.y + b2.y) + (c.y + d.y) + 64.0f * ((da * da + db * db) + (dc * dc + dd * dd));
            __hip_atomic_store(xbuf + ((size_t)(u.pm * BM + row) * 4 + u.pn), ((unsigned long long)__float_as_uint(m2) << 32) | __float_as_uint(mt), __ATOMIC_RELAXED, __HIP_MEMORY_SCOPE_AGENT); }
        asm volatile("s_waitcnt vmcnt(0)" ::: "memory");
        if (lane == 0) __hip_atomic_fetch_add(cnt + 64 * u.pm, 1u, __ATOMIC_RELAXED, __HIP_MEMORY_SCOPE_AGENT);
        if (wid == 0) { unsigned sp = 0;
            while ((unsigned)__builtin_amdgcn_readfirstlane(__hip_atomic_load(cnt + 64 * u.pm, __ATOMIC_RELAXED, __HIP_MEMORY_SCOPE_AGENT)) < 32u) { __builtin_amdgcn_s_sleep(2); if (++sp > (1u << 22)) break; }
            __builtin_amdgcn_fence(__ATOMIC_ACQUIRE, "agent"); }
        asm volatile("s_waitcnt vmcnt(0) lgkmcnt(0)" ::: "memory"); __builtin_amdgcn_s_barrier(); asm volatile("" ::: "memory");
        if (lane < 32) { const unsigned long long* slot = xbuf + (size_t)(u.pm * BM + row) * 4; float mt[4], m2[4]; float ms = 0.f;
#pragma unroll
            for (int t = 0; t < 4; ++t) { const unsigned long long w = __hip_atomic_load(slot + t, __ATOMIC_RELAXED, __HIP_MEMORY_SCOPE_AGENT); mt[t] = __uint_as_float((unsigned)w); m2[t] = __uint_as_float((unsigned)(w >> 32)); ms += mt[t]; }
            const float mean = ms * 0.25f; float q = 0.f;
#pragma unroll
            for (int t = 0; t < 4; ++t) { const float dm = mt[t] - mean; q += m2[t] + 256.0f * dm * dm; }
            Sx[row] = (f32x2){mean, 1.0f / sqrtf(q * (1.0f / 1024.0f) + LN_EPS)}; }
        asm volatile("s_waitcnt lgkmcnt(0)" ::: "memory"); __builtin_amdgcn_s_barrier(); asm volatile("" ::: "memory");
        int fr6 = fr, fq6 = fq; asm volatile("" : "+v"(fr6), "+v"(fq6));
        const int col6 = u.pn * BM + wc * 32 + 8 * fq6;
#pragma unroll
        for (int bj = 0; bj < 2; ++bj) { const f32x4 gv0 = *(const f32x4*)(g + col6 + bj * HALF), gv1 = *(const f32x4*)(g + col6 + bj * HALF + 4), bv0 = *(const f32x4*)(b + col6 + bj * HALF), bv1 = *(const f32x4*)(b + col6 + bj * HALF + 4);
#pragma unroll
            for (int ai = 0; ai < 2; ++ai)
#pragma unroll
                for (int m = 0; m < 4; ++m) { const int r = ai * HALF + wr * 64 + m * 16 + fr6; const f32x2 sr = Sx[r]; const size_t off = (size_t)(u.pm * BM + r) * DM + col6 + bj * HALF;
                    const f32x4 o0 = (acc[ai][bj][m][0] - sr.x) * sr.y * gv0 + bv0, o1 = (acc[ai][bj][m][1] - sr.x) * sr.y * gv1 + bv1;
                    if constexpr (WRITE_F32) { *(f32x4*)(X + off) = o0; *(f32x4*)(X + off + 4) = o1; }
                    if constexpr (WRITE_F16) { const h16x4 h0 = __builtin_convertvector(o0, h16x4), h1 = __builtin_convertvector(o1, h16x4); *(h16x8*)(Ho + off) = __builtin_shufflevector(h0, h1, 0, 1, 2, 3, 4, 5, 6, 7); } }
            asm volatile("" ::: "memory"); }
    }
};

template <bool F16 = false, class Epi, class Sched>
__device__ __forceinline__ void gemm_phase(LAS unsigned char* lds, const Gemm g, const Sched& Sc, const Epi& E, int tid) {
    const int wid = __builtin_amdgcn_readfirstlane(tid >> 6), lane = tid & 63, wr = wid >> 2, wc = wid & 3, fr = lane & 15, fq = lane >> 4;
    const int nt = launder_i(g.K / BK);
    unsigned voffA[2], voffB[2];
#pragma unroll
    for (int i = 0; i < 2; ++i) { int R, C; stage_rc(tid * 16 + i * 8192, R, C); const int Rb = Epi::PERM ? ((R & ~31) + perm32(R & 31)) : R;
        voffA[i] = (unsigned)(R * g.lda + C) * 2u; voffB[i] = (unsigned)(Rb * g.bmul * g.ldb + C) * 2u; }
    const size_t kstep = (size_t)(BK * 2);
    const size_t hsA = g.hstepA, hsB = g.hstepB;
    const unsigned ldsw = (unsigned)wid * 1024u;
    const int aoff = lds_byte(wr * 64 + fr, fq * 8), boff = lds_byte(wc * 32 + fr, fq * 8);
#define PG8_SA(b, h) (((b) * 2 + (h)) * HTB)
#define PG8_SB(b, h) ((4 + (b) * 2 + (h)) * HTB)
#define PG8_STAGE(bufoff, gbase, voff) do { _Pragma("unroll") for (int _i = 0; _i < 2; ++_i) \
        __builtin_amdgcn_global_load_lds((const unsigned*)((const char*)(gbase) + (voff)[_i]), (LAS unsigned*)(lds + (bufoff) + ldsw + _i * 8192), 16, 0, 0); } while (0)
#define PG8_LDA(dst, b, h) do { _Pragma("unroll") for (int m = 0; m < 4; ++m) _Pragma("unroll") for (int k = 0; k < 2; ++k) dst[m][k] = *(const LAS bf16x8*)(lds + PG8_SA(b, h) + aoff + m * 2048 + k * 1024); } while (0)
#define PG8_LDB(dst, b, h) do { _Pragma("unroll") for (int n = 0; n < 2; ++n) _Pragma("unroll") for (int k = 0; k < 2; ++k) dst[n][k] = *(const LAS bf16x8*)(lds + PG8_SB(b, h) + boff + n * 2048 + k * 1024); } while (0)
#define PG8_MMA(ai, bj, At, Bt) do { __builtin_amdgcn_s_setprio(1); _Pragma("unroll") for (int m = 0; m < 4; ++m) _Pragma("unroll") for (int n = 0; n < 2; ++n) _Pragma("unroll") for (int k = 0; k < 2; ++k) \
        { if constexpr (F16) acc[ai][bj][m][n] = __builtin_amdgcn_mfma_f32_16x16x32_f16(__builtin_bit_cast(h16x8, Bt[n][k]), __builtin_bit_cast(h16x8, At[m][k]), acc[ai][bj][m][n], 0, 0, 0); \
          else acc[ai][bj][m][n] = __builtin_amdgcn_mfma_f32_16x16x32_bf16(Bt[n][k], At[m][k], acc[ai][bj][m][n], 0, 0, 0); } __builtin_amdgcn_s_setprio(0); } while (0)
#define PG8_WAIT_V(n) asm volatile("s_waitcnt vmcnt(" #n ")" ::: "memory")
#define PG8_WAIT_L(n) asm volatile("s_waitcnt lgkmcnt(" #n ")" ::: "memory")
#define PG8_BAR __builtin_amdgcn_s_barrier()
#define PG8_SCHED __builtin_amdgcn_sched_barrier(0)
    Unit cur, nxt; int ui = 0;
    if (!Sc.next(0, cur)) return;
    Acc acc;
#pragma unroll
    for (int a = 0; a < 2; ++a)
#pragma unroll
        for (int b = 0; b < 2; ++b)
#pragma unroll
            for (int m = 0; m < 4; ++m)
#pragma unroll
                for (int n = 0; n < 2; ++n) { const float z = zero_f(); acc[a][b][m][n] = (f32x4){z, z, z, z}; }
    bf16x8 At[4][2], B0[2][2], B1[2][2];
    const char* cA = cur.a; const char* cB = cur.b;
    PG8_STAGE(PG8_SB(0, 0), cB, voffB); PG8_STAGE(PG8_SB(0, 1), cB + hsB, voffB); PG8_STAGE(PG8_SA(0, 0), cA, voffA); PG8_STAGE(PG8_SA(0, 1), cA + hsA, voffA);
    if (wr == 1) PG8_BAR;
    PG8_WAIT_V(2); PG8_BAR;
    PG8_STAGE(PG8_SB(1, 0), cB + kstep, voffB); PG8_STAGE(PG8_SA(1, 0), cA + kstep, voffA); PG8_STAGE(PG8_SB(1, 1), cB + hsB + kstep, voffB);
    PG8_WAIT_V(6); PG8_BAR;
    for (;;) {
        const bool has_next = Sc.next(ui + 1, nxt);
        const char* nA = has_next ? nxt.a : cA; const char* nB = has_next ? nxt.b : cB;
#pragma nounroll
        for (int t = 0; t < nt; t += 2) {
            const bool last = (t == nt - 2);
            const char* a1 = cA + (size_t)(t + 1) * kstep;
            const char* a2 = last ? nA : cA + (size_t)(t + 2) * kstep; const char* b2 = last ? nB : cB + (size_t)(t + 2) * kstep;
            const char* a3 = a2 + kstep; const char* b3 = b2 + kstep;
            PG8_LDB(B0, 0, 0); PG8_LDB(B1, 0, 1); PG8_SCHED; PG8_LDA(At, 0, 0); PG8_STAGE(PG8_SA(1, 1), a1 + hsA, voffA);
            PG8_WAIT_V(8); PG8_WAIT_L(0); PG8_BAR; PG8_MMA(0, 0, At, B0); PG8_MMA(0, 1, At, B1); PG8_BAR; PG8_SCHED;
            PG8_LDA(At, 0, 1); PG8_STAGE(PG8_SB(0, 0), b2, voffB); PG8_STAGE(PG8_SB(0, 1), b2 + hsB, voffB); PG8_STAGE(PG8_SA(0, 0), a2, voffA);
            PG8_WAIT_V(8); PG8_WAIT_L(0); PG8_BAR; PG8_MMA(1, 0, At, B0); PG8_MMA(1, 1, At, B1); PG8_BAR; PG8_SCHED;
            PG8_LDB(B0, 1, 0); PG8_LDB(B1, 1, 1); PG8_SCHED; PG8_LDA(At, 1, 0); PG8_STAGE(PG8_SA(0, 1), a2 + hsA, voffA);
            PG8_WAIT_V(8); PG8_WAIT_L(0); PG8_BAR; PG8_MMA(0, 0, At, B0); PG8_MMA(0, 1, At, B1); PG8_BAR; PG8_SCHED;
            PG8_LDA(At, 1, 1); PG8_STAGE(PG8_SB(1, 0), b3, voffB); PG8_STAGE(PG8_SB(1, 1), b3 + hsB, voffB); PG8_STAGE(PG8_SA(1, 0), a3, voffA);
            PG8_WAIT_V(8); PG8_WAIT_L(0); PG8_BAR; PG8_MMA(1, 0, At, B0); PG8_MMA(1, 1, At, B1); PG8_BAR; PG8_SCHED;
        }
        if (wr == 0) PG8_BAR;
        if constexpr (!Epi::AFTER_DRAIN) { int fr2 = fr, fq2 = fq; asm volatile("" : "+v"(fr2), "+v"(fq2)); E(acc, cur, wr, wc, fr2, fq2); }
        if (!has_next) break;
#pragma unroll
        for (int a = 0; a < 2; ++a)
#pragma unroll
            for (int b = 0; b < 2; ++b)
#pragma unroll
                for (int m = 0; m < 4; ++m)
#pragma unroll
                    for (int n = 0; n < 2; ++n) { const float z = zero_f(); acc[a][b][m][n] = (f32x4){z, z, z, z}; }
        cur = nxt; cA = nA; cB = nB; ++ui;
        if (wr == 1) PG8_BAR;
    }
    PG8_WAIT_V(0);
    PG8_BAR;
    if constexpr (Epi::AFTER_DRAIN) { int fr2 = fr, fq2 = fq, ln2 = lane; asm volatile("" : "+v"(fr2), "+v"(fq2), "+v"(ln2)); E.fused(acc, cur, wr, wc, fr2, fq2, lds, wid, ln2); }
#undef PG8_SA
#undef PG8_SB
#undef PG8_STAGE
#undef PG8_LDA
#undef PG8_LDB
#undef PG8_MMA
#undef PG8_WAIT_V
#undef PG8_WAIT_L
#undef PG8_BAR
#undef PG8_SCHED
}
}

namespace att {
constexpr int KVBLK = 64, SHM_V = 64 * 128 * 2, SHM_K = 64 * 400;
constexpr int LDS_V = 0, LDS_K = 3 * SHM_V, LDS_WS = 3 * SHM_V + 2 * SHM_K, LDS_QR = LDS_WS + NW * 64 * 4, LDS_BYTES = LDS_QR + NW * 32 * 144;
static_assert(LDS_BYTES <= 146944, "attention LDS");
constexpr float SCALE = 0.07216878364870323f;
constexpr float THR = 8.f;
#define KSWZ(row, colB) ((row) * 400 + (colB))
#define SBAR() __builtin_amdgcn_sched_barrier(0)
__device__ __forceinline__ int crow(int r, int hi) { return (r & 3) + 8 * (r >> 2) + 4 * hi; }
__device__ __forceinline__ int v_st(int k, int c) { const int kk = (k & ~0xC) | ((k & 4) << 1) | ((k & 8) >> 1); return ((kk >> 3) * 4 + (c >> 5)) * 512 + ((kk & 7) * 32 + (c & 31)) * 2; }
__device__ __forceinline__ int v_rd_base(int lane) { return ((lane & 3) << 3) | (((lane >> 2) & 3) << 6) | (((lane >> 4) & 1) << 5) | (((lane >> 5) & 1) << 8); }
constexpr int v_rd_off(int d0, int ks, int half) { return d0 * 512 + ks * 4096 + half * 2048; }
template <int OFF> __device__ __forceinline__ s16x4 tr_read(int vb) { s16x4 r; asm volatile("ds_read_b64_tr_b16 %0, %1 offset:%2" : "=&v"(r) : "v"(vb), "i"(OFF) : "memory"); return r; }
template <int D0> __device__ __forceinline__ void pv_one(f32x16& od, int vb, bf16x8 pa0, bf16x8 pa1, bf16x8 pa2, bf16x8 pa3) {
    const s16x4 l0 = tr_read<v_rd_off(D0, 0, 0)>(vb), h0 = tr_read<v_rd_off(D0, 0, 1)>(vb), l1 = tr_read<v_rd_off(D0, 1, 0)>(vb), h1 = tr_read<v_rd_off(D0, 1, 1)>(vb);
    const s16x4 l2 = tr_read<v_rd_off(D0, 2, 0)>(vb), h2 = tr_read<v_rd_off(D0, 2, 1)>(vb), l3 = tr_read<v_rd_off(D0, 3, 0)>(vb), h3 = tr_read<v_rd_off(D0, 3, 1)>(vb);
    asm volatile("s_waitcnt lgkmcnt(0)" ::: "memory"); SBAR();
#define PK(L, H) (bf16x8){L[0], L[1], L[2], L[3], H[0], H[1], H[2], H[3]}
    od = __builtin_amdgcn_mfma_f32_32x32x16_bf16(pa0, PK(l0, h0), od, 0, 0, 0);
    od = __builtin_amdgcn_mfma_f32_32x32x16_bf16(pa1, PK(l1, h1), od, 0, 0, 0);
    od = __builtin_amdgcn_mfma_f32_32x32x16_bf16(pa2, PK(l2, h2), od, 0, 0, 0);
    od = __builtin_amdgcn_mfma_f32_32x32x16_bf16(pa3, PK(l3, h3), od, 0, 0, 0);
#undef PK
}
__device__ __forceinline__ void qkt(f32x16& p0, f32x16& p1, const char* Ks, const bf16x8* qr, const char* qrl, int r32, int hi) {
    p0 = f32x16{}; p1 = f32x16{};
#pragma unroll
    for (int d0 = 0; d0 < 12; ++d0) { const int cb = (d0 * 16 + hi * 8) * 2;
        const bf16x8 b0 = *reinterpret_cast<const bf16x8*>(Ks + KSWZ(r32, cb));
        const bf16x8 b1 = *reinterpret_cast<const bf16x8*>(Ks + KSWZ(32 + r32, cb));
        const bf16x8 q = (d0 < 8) ? qr[d0 < 8 ? d0 : 0] : *reinterpret_cast<const bf16x8*>(qrl + (d0 - 8) * 32);
        p0 = __builtin_amdgcn_mfma_f32_32x32x16_bf16(b0, q, p0, 0, 0, 0);
        p1 = __builtin_amdgcn_mfma_f32_32x32x16_bf16(b1, q, p1, 0, 0, 0); }
}
__device__ __forceinline__ void partialSM(f32x16& p0, f32x16& p1, float& m_reg, float& mn, float& alpha) {
    constexpr float C = SCALE * 1.4426950408889634f;
    float pmax = p0[0];
#pragma unroll
    for (int r = 1; r < 16; ++r) pmax = fmaxf(pmax, p0[r]);
#pragma unroll
    for (int r = 0; r < 16; ++r) pmax = fmaxf(pmax, p1[r]);
    { auto rr = __builtin_amdgcn_permlane32_swap(__float_as_uint(pmax), __float_as_uint(pmax), false, false); pmax = fmaxf(__uint_as_float(rr[0]), __uint_as_float(rr[1])); }
    if (__builtin_expect(__all(pmax - m_reg <= THR / SCALE), 1)) { mn = m_reg; alpha = 1.f; }
    else { mn = fmaxf(m_reg, pmax); alpha = __builtin_amdgcn_exp2f((m_reg - mn) * C); m_reg = mn; }
    const float mnC = -mn * C;
#pragma unroll
    for (int r = 0; r < 16; ++r) p0[r] = fmaf(p0[r], C, mnC);
#pragma unroll
    for (int r = 0; r < 16; ++r) p1[r] = fmaf(p1[r], C, mnC);
#pragma unroll
    for (int r = 0; r < 16; ++r) p0[r] = __builtin_amdgcn_exp2f(p0[r]);
}
__device__ __forceinline__ void finishSM(f32x16& p0, f32x16& p1, float alpha, float& l_reg, bf16x8& pa0, bf16x8& pa1, bf16x8& pa2, bf16x8& pa3) {
#pragma unroll
    for (int r = 0; r < 16; ++r) p1[r] = __builtin_amdgcn_exp2f(p1[r]);
    float ps = 0.f;
#pragma unroll
    for (int r = 0; r < 16; ++r) ps += p0[r];
#pragma unroll
    for (int r = 0; r < 16; ++r) ps += p1[r];
    { auto rr = __builtin_amdgcn_permlane32_swap(__float_as_uint(ps), __float_as_uint(ps), false, false); ps = __uint_as_float(rr[0]) + __uint_as_float(rr[1]); }
    l_reg = l_reg * alpha + ps;
#define PK4(P, BASE, OUT) do { unsigned a0 = cvt_pk_bf16(P[BASE + 0], P[BASE + 1]), a1 = cvt_pk_bf16(P[BASE + 2], P[BASE + 3]);   \
    unsigned b0 = cvt_pk_bf16(P[BASE + 4], P[BASE + 5]), b1 = cvt_pk_bf16(P[BASE + 6], P[BASE + 7]);                              \
    auto r0 = __builtin_amdgcn_permlane32_swap(a0, b0, false, false); auto r1 = __builtin_amdgcn_permlane32_swap(a1, b1, false, false); \
    u32x4 w = {r0[0], r1[0], r0[1], r1[1]}; OUT = *reinterpret_cast<bf16x8*>(&w); } while (0)
    PK4(p0, 0, pa0); PK4(p0, 8, pa1); PK4(p1, 0, pa2); PK4(p1, 8, pa3);
#undef PK4
}
template <int D0> __device__ __forceinline__ void v_rd8(s16x4* f, int vb) {
    f[0] = tr_read<v_rd_off(D0, 0, 0)>(vb); f[1] = tr_read<v_rd_off(D0, 0, 1)>(vb); f[2] = tr_read<v_rd_off(D0, 1, 0)>(vb); f[3] = tr_read<v_rd_off(D0, 1, 1)>(vb);
    f[4] = tr_read<v_rd_off(D0, 2, 0)>(vb); f[5] = tr_read<v_rd_off(D0, 2, 1)>(vb); f[6] = tr_read<v_rd_off(D0, 3, 0)>(vb); f[7] = tr_read<v_rd_off(D0, 3, 1)>(vb);
}
__device__ __forceinline__ void pv_mma(f32x16& od, const s16x4* f, bf16x8 pa0, bf16x8 pa1, bf16x8 pa2, bf16x8 pa3) {
#define PK(L, H) (bf16x8){L[0], L[1], L[2], L[3], H[0], H[1], H[2], H[3]}
    od = __builtin_amdgcn_mfma_f32_32x32x16_bf16(pa0, PK(f[0], f[1]), od, 0, 0, 0);
    od = __builtin_amdgcn_mfma_f32_32x32x16_bf16(pa1, PK(f[2], f[3]), od, 0, 0, 0);
    od = __builtin_amdgcn_mfma_f32_32x32x16_bf16(pa2, PK(f[4], f[5]), od, 0, 0, 0);
    od = __builtin_amdgcn_mfma_f32_32x32x16_bf16(pa3, PK(f[6], f[7]), od, 0, 0, 0);
#undef PK
}
__device__ __forceinline__ void pv_d0(f32x16* o, int vb, bf16x8 pa0, bf16x8 pa1, bf16x8 pa2, bf16x8 pa3) {
    s16x4 fa[8], fb[8];
    __builtin_amdgcn_s_setprio(1);
    v_rd8<0>(fa, vb); v_rd8<1>(fb, vb);
    asm volatile("s_waitcnt lgkmcnt(8)" ::: "memory"); SBAR(); pv_mma(o[0], fa, pa0, pa1, pa2, pa3); SBAR();
    v_rd8<2>(fa, vb);
    asm volatile("s_waitcnt lgkmcnt(8)" ::: "memory"); SBAR(); pv_mma(o[1], fb, pa0, pa1, pa2, pa3); SBAR();
    v_rd8<3>(fb, vb);
    asm volatile("s_waitcnt lgkmcnt(8)" ::: "memory"); SBAR(); pv_mma(o[2], fa, pa0, pa1, pa2, pa3); SBAR();
    asm volatile("s_waitcnt lgkmcnt(0)" ::: "memory"); SBAR(); pv_mma(o[3], fb, pa0, pa1, pa2, pa3);
    __builtin_amdgcn_s_setprio(0);
}
__device__ __forceinline__ void pv_psm(f32x16* o, int vb, bf16x8 pa0, bf16x8 pa1, bf16x8 pa2, bf16x8 pa3, f32x16& p0, f32x16& p1, float& m_reg, float& alpha) {
    constexpr float C = SCALE * 1.4426950408889634f;
    s16x4 fa[8], fb[8];
    __builtin_amdgcn_s_setprio(1);
    v_rd8<0>(fa, vb); v_rd8<1>(fb, vb);
    asm volatile("s_waitcnt lgkmcnt(8)" ::: "memory"); SBAR(); pv_mma(o[0], fa, pa0, pa1, pa2, pa3);
    float pmax = p0[0];
#pragma unroll
    for (int r = 1; r < 16; ++r) pmax = fmaxf(pmax, p0[r]);
    SBAR();
    v_rd8<2>(fa, vb);
    asm volatile("s_waitcnt lgkmcnt(8)" ::: "memory"); SBAR(); pv_mma(o[1], fb, pa0, pa1, pa2, pa3);
#pragma unroll
    for (int r = 0; r < 16; ++r) pmax = fmaxf(pmax, p1[r]);
    { auto rr = __builtin_amdgcn_permlane32_swap(__float_as_uint(pmax), __float_as_uint(pmax), false, false); pmax = fmaxf(__uint_as_float(rr[0]), __uint_as_float(rr[1])); }
    const bool keep = __all(pmax - m_reg <= THR / SCALE);
    const float mn = keep ? m_reg : fmaxf(m_reg, pmax);
    alpha = keep ? 1.f : __builtin_amdgcn_exp2f((m_reg - mn) * C);
    m_reg = mn;
    const float mnC = -mn * C;
    SBAR();
    v_rd8<3>(fb, vb);
    asm volatile("s_waitcnt lgkmcnt(8)" ::: "memory"); SBAR(); pv_mma(o[2], fa, pa0, pa1, pa2, pa3);
#pragma unroll
    for (int r = 0; r < 16; ++r) p0[r] = fmaf(p0[r], C, mnC);
#pragma unroll
    for (int r = 0; r < 16; ++r) p1[r] = fmaf(p1[r], C, mnC);
    SBAR();
    asm volatile("s_waitcnt lgkmcnt(0)" ::: "memory"); SBAR(); pv_mma(o[3], fb, pa0, pa1, pa2, pa3);
#pragma unroll
    for (int r = 0; r < 16; ++r) p0[r] = __builtin_amdgcn_exp2f(p0[r]);
    __builtin_amdgcn_s_setprio(0);
}
__device__ __forceinline__ void attn_unit(int h, int q0, const bf16_t* __restrict__ Q, const bf16_t* __restrict__ KV, const bf16_t* __restrict__ KR, bf16_t* __restrict__ O, char* lds, LAS unsigned char* ldsl, int tid_in) {
    int tid = tid_in; asm volatile("" : "+v"(tid));
    const int wid = tid >> 6, lane = tid & 63, r32 = lane & 31, hi = lane >> 5;
    char* V_lds = lds + LDS_V; char* K_lds = lds + LDS_K;
    float* ws = (float*)(lds + LDS_WS) + wid * 64; float* li_l = ws; float* al_l = ws + 32;
    float m_reg = -1e30f, l_reg = 0.f; f32x16 o[4] = {}; bf16x8 qr[8];
    const bf16_t* Qw = Q + ((size_t)h * S + q0 + wid * 32 + r32) * 192 + hi * 8;
#pragma unroll
    for (int d0 = 0; d0 < 8; ++d0) qr[d0] = *reinterpret_cast<const bf16x8*>(Qw + d0 * 16);
    char* qrl = lds + LDS_QR + wid * (32 * 144) + r32 * 144 + hi * 16;
#pragma unroll
    for (int d0 = 8; d0 < 12; ++d0) *reinterpret_cast<bf16x8*>(qrl + (d0 - 8) * 32) = *reinterpret_cast<const bf16x8*>(Qw + d0 * 16);
    const bf16_t* Kh = KV + (size_t)h * S * 128; const bf16_t* Vh = KV + (size_t)(8 + h) * S * 128;
    const int vb0 = (int)(uintptr_t)V_lds + v_rd_base(lane);
    const int widu = __builtin_amdgcn_readfirstlane(wid);
    const char* gK0; const char* gK1; const char* gK2; unsigned iK0, iK1, iK2;
#define KSRC(t, G, I) do { const int ci_ = (widu + 8 * (t)) * 64 + lane; const int row_ = ci_ / 25; int ch_ = ci_ - row_ * 25; if (ch_ == 24) ch_ = 0; \
    if (ch_ < 16) { G = (const char*)(Kh + (size_t)row_ * 128 + ch_ * 8); I = 16384u; } else { G = (const char*)(KR + (size_t)row_ * 64 + (ch_ - 16) * 8); I = 8192u; } } while (0)
    KSRC(0, gK0, iK0); KSRC(1, gK1, iK1); KSRC(2, gK2, iK2);
    unsigned voffV0;
#define VSRC(t, V_) do { const int st_ = 2 * (widu + 8 * (t)) + (lane >> 5); const int kk_ = (st_ >> 2) * 8 + ((lane & 31) >> 2); const int k_ = (kk_ & ~0xC) | ((kk_ & 4) << 1) | ((kk_ & 8) >> 1); \
    const int c_ = (st_ & 3) * 32 + (lane & 3) * 8; V_ = (unsigned)(k_ * 128 + c_) * 2u; } while (0)
    VSRC(0, voffV0);
#undef VSRC
    LAS unsigned char* Kd = ldsl + LDS_K + widu * 1024; LAS unsigned char* Vd = ldsl + LDS_V + widu * 1024;
#define DMA_TILE(kt, kb, vs) do { const char* vt_ = (const char*)(Vh + (size_t)(kt) * 64 * 128); \
    __builtin_amdgcn_global_load_lds((const unsigned*)gK0, (LAS unsigned*)(Kd + (kb) * SHM_K), 16, 0, 0); gK0 += iK0; \
    __builtin_amdgcn_global_load_lds((const unsigned*)gK1, (LAS unsigned*)(Kd + (kb) * SHM_K + 8192), 16, 0, 0); gK1 += iK1; \
    __builtin_amdgcn_global_load_lds((const unsigned*)gK2, (LAS unsigned*)(Kd + (kb) * SHM_K + 16384), 16, 0, 0); gK2 += iK2; \
    if (widu == 0) { const char* g3_; unsigned i3_; KSRC(3, g3_, i3_); g3_ += (size_t)(kt) * i3_; __builtin_amdgcn_global_load_lds((const unsigned*)g3_, (LAS unsigned*)(Kd + (kb) * SHM_K + 24576), 16, 0, 0); } \
    __builtin_amdgcn_global_load_lds((const unsigned*)(vt_ + voffV0), (LAS unsigned*)(Vd + (vs) * SHM_V), 16, 0, 0); \
    __builtin_amdgcn_global_load_lds((const unsigned*)(vt_ + 8192 + voffV0), (LAS unsigned*)(Vd + (vs) * SHM_V + 8192), 16, 0, 0); } while (0)
#define RESC(a_) do { if (__any((a_) != 1.f)) { if (hi == 0) al_l[r32] = (a_); asm volatile("s_waitcnt lgkmcnt(0)" ::: "memory"); \
    _Pragma("unroll") for (int d = 0; d < 4; ++d) _Pragma("unroll") for (int r = 0; r < 16; ++r) o[d][r] *= al_l[crow(r, hi)]; } } while (0)
#define LANDED() do { asm volatile("s_waitcnt vmcnt(0)" ::: "memory"); __syncthreads(); } while (0)
    f32x16 pA0, pA1, pB0, pB1; float mnA, mnB, alA, alB; bf16x8 pa0, pa1, pa2, pa3; const int NT = S / KVBLK;
    DMA_TILE(0, 0, 0); LANDED();
    DMA_TILE(1, 1, 1);
    qkt(pA0, pA1, K_lds, qr, qrl, r32, hi); partialSM(pA0, pA1, m_reg, mnA, alA);
    LANDED();
    int vprev = 0, vnext = 2;
#define VROT() do { vprev = (vprev == 2) ? 0 : vprev + 1; vnext = (vnext == 2) ? 0 : vnext + 1; } while (0)
    for (int j = 1; j + 1 < NT; j += 2) {
        DMA_TILE(j + 1, 0, vnext);
        SBAR(); qkt(pB0, pB1, K_lds + SHM_K, qr, qrl, r32, hi);
        finishSM(pA0, pA1, alA, l_reg, pa0, pa1, pa2, pa3); SBAR();
        pv_psm(o, vb0 + vprev * SHM_V, pa0, pa1, pa2, pa3, pB0, pB1, m_reg, alB);
        RESC(alB); LANDED(); VROT();
        DMA_TILE(j + 2, 1, vnext);
        SBAR(); qkt(pA0, pA1, K_lds, qr, qrl, r32, hi);
        finishSM(pB0, pB1, alB, l_reg, pa0, pa1, pa2, pa3); SBAR();
        pv_psm(o, vb0 + vprev * SHM_V, pa0, pa1, pa2, pa3, pA0, pA1, m_reg, alA);
        RESC(alA); LANDED(); VROT();
    }
    SBAR(); qkt(pB0, pB1, K_lds + SHM_K, qr, qrl, r32, hi);
    finishSM(pA0, pA1, alA, l_reg, pa0, pa1, pa2, pa3); SBAR();
    pv_d0(o, vb0 + vprev * SHM_V, pa0, pa1, pa2, pa3); partialSM(pB0, pB1, m_reg, mnB, alB);
    RESC(alB);
    finishSM(pB0, pB1, alB, l_reg, pa0, pa1, pa2, pa3); SBAR();
    pv_d0(o, vb0 + ((vprev == 2) ? 0 : vprev + 1) * SHM_V, pa0, pa1, pa2, pa3);
#undef VROT
#undef LANDED
#undef DMA_TILE
#undef KSRC
    { int tid2 = tid_in; asm volatile("" : "+v"(tid2));
      const int wid2 = tid2 >> 6, lane2 = tid2 & 63, r32b = lane2 & 31, hib = lane2 >> 5;
      float* li2 = (float*)(lds + LDS_WS) + wid2 * 64;
      if (hib == 0) li2[r32b] = l_reg; asm volatile("s_waitcnt lgkmcnt(0)" ::: "memory");
      float rli[16];
#pragma unroll
      for (int r = 0; r < 16; ++r) rli[r] = __builtin_amdgcn_rcpf(li2[crow(r, hib)]);
      bf16_t* Ow = O + (size_t)(q0 + wid2 * 32) * 1024 + h * 128;
#pragma unroll
      for (int r = 0; r < 16; ++r) { const int orow = crow(r, hib);
#pragma unroll
          for (int d0 = 0; d0 < 4; ++d0) { const float v = o[d0][r] * rli[r]; Ow[(size_t)orow * 1024 + d0 * 32 + r32b] = (bf16_t)(cvt_pk_bf16(v, v) & 0xffffu); } } }
    __syncthreads();
#undef RESC
}
#undef SBAR
}


namespace att8 {
constexpr int KVBLK = 64, KROW = 208, VROW = 80, SHM_K = 64 * KROW  , SHM_V = 128 * VROW  ;
constexpr int LDS_V = 0, LDS_K = 3 * SHM_V, LDS_WS = LDS_K + 2 * SHM_K, LDS_BYTES = LDS_WS + NW * 64 * 4;
constexpr float SCALE = 0.07216878364870323f;
constexpr float THR = 3.f, PSHIFT = 4.f;
__device__ __forceinline__ int crow(int r, int hi) { return (r & 3) + 8 * (r >> 2) + 4 * hi; }
#define MFMA8(a_, b_, c_) __builtin_amdgcn_mfma_scale_f32_32x32x64_f8f6f4(a_, b_, c_, 0, 0, 0, 0x7f7f7f7f, 0, 0x7f7f7f7f)
__device__ __forceinline__ v8i ld32(const char* p) { const u32x4 a = *reinterpret_cast<const u32x4*>(p), b = *reinterpret_cast<const u32x4*>(p + 16); return (v8i){(int)a.x, (int)a.y, (int)a.z, (int)a.w, (int)b.x, (int)b.y, (int)b.z, (int)b.w}; }
__device__ __forceinline__ void qkt(f32x16& p0, f32x16& p1, const char* Ks, const v8i* qf, const f32x16& negm, int r32, int hi) {
#pragma unroll
    for (int kk = 0; kk < 3; ++kk) { const v8i a0 = ld32(Ks + r32 * KROW + 64 * kk + 32 * hi), a1 = ld32(Ks + (32 + r32) * KROW + 64 * kk + 32 * hi);
        if (kk == 0) { p0 = MFMA8(a0, qf[0], negm); p1 = MFMA8(a1, qf[0], negm); } else { p0 = MFMA8(a0, qf[kk], p0); p1 = MFMA8(a1, qf[kk], p1); } }
}
__device__ __forceinline__ void partialSM(f32x16& p0, f32x16& p1, float& m_reg, f32x16& negm, float& alpha) {
    constexpr float THRL = THR * 1.4426950408889634f;
    float pmax = p0[0];
#pragma unroll
    for (int r = 1; r < 16; ++r) pmax = fmaxf(pmax, p0[r]);
#pragma unroll
    for (int r = 0; r < 16; ++r) pmax = fmaxf(pmax, p1[r]);
    { auto rr = __builtin_amdgcn_permlane32_swap(__float_as_uint(pmax), __float_as_uint(pmax), false, false); pmax = fmaxf(__uint_as_float(rr[0]), __uint_as_float(rr[1])); }
    alpha = 1.f;
    if (__builtin_expect(!__all(pmax <= PSHIFT + THRL), 0)) {
        const float dl = fmaxf(pmax - PSHIFT, 0.f);
        m_reg += dl; alpha = __builtin_amdgcn_exp2f(-dl);
#pragma unroll
        for (int r = 0; r < 16; ++r) { p0[r] -= dl; p1[r] -= dl; }
        const float nm = PSHIFT - m_reg;
#pragma unroll
        for (int r = 0; r < 16; ++r) negm[r] = nm;
    }
#pragma unroll
    for (int r = 0; r < 16; ++r) p0[r] = __builtin_amdgcn_exp2f(p0[r]);
}
__device__ __forceinline__ void finishSM(f32x16& p0, f32x16& p1, v8i& pf) {
#pragma unroll
    for (int r = 0; r < 16; ++r) p1[r] = __builtin_amdgcn_exp2f(p1[r]);
#pragma unroll
    for (int i = 0; i < 4; ++i) { const unsigned x = pk4_fp8((f32x4){p0[4 * i], p0[4 * i + 1], p0[4 * i + 2], p0[4 * i + 3]}), y = pk4_fp8((f32x4){p1[4 * i], p1[4 * i + 1], p1[4 * i + 2], p1[4 * i + 3]});
        auto rr = __builtin_amdgcn_permlane32_swap(x, y, false, false); pf[2 * i] = (int)rr[0]; pf[2 * i + 1] = (int)rr[1]; }
}
__device__ __forceinline__ void pv(f32x16* o, const char* Vs, v8i pf, int r32, int hi) {
    const v8i ones = {0x38383838, 0x38383838, 0x38383838, 0x38383838, 0x38383838, 0x38383838, 0x38383838, 0x38383838};
    __builtin_amdgcn_s_setprio(1);
#pragma unroll
    for (int db = 0; db < 4; ++db) { const v8i b = ld32(Vs + (32 * db + r32) * VROW + 32 * hi); o[db] = MFMA8(pf, b, o[db]); }
    o[4] = MFMA8(pf, ones, o[4]);
    __builtin_amdgcn_s_setprio(0);
}
__device__ __forceinline__ void attn_unit(int h, int q0, const unsigned char* __restrict__ Q8, const unsigned char* __restrict__ K8, const unsigned char* __restrict__ KR8, const unsigned char* __restrict__ V8T,
                                          bf16_t* __restrict__ O, char* lds, LAS unsigned char* ldsl, int tid_in) {
    int tid = tid_in; asm volatile("" : "+v"(tid));
    const int wid = tid >> 6, lane = tid & 63, r32 = lane & 31, hi = lane >> 5;
    const int widu = __builtin_amdgcn_readfirstlane(wid);
    char* V_lds = lds + LDS_V; char* K_lds = lds + LDS_K;
    float* ws = (float*)(lds + LDS_WS) + wid * 64; float* al_l = ws + 32;
    float m_reg = 0.f; f32x16 o[5] = {}; v8i qf[3]; f32x16 negm;
#pragma unroll
    for (int r = 0; r < 16; ++r) negm[r] = PSHIFT;
    { const char* Qrow = (const char*)(Q8 + ((size_t)h * S + q0 + wid * 32 + r32) * 192 + 32 * hi);
#pragma unroll
      for (int kk = 0; kk < 3; ++kk) qf[kk] = ld32(Qrow + 64 * kk); }
    const char* gKa; const char* gKb; unsigned iKa, iKb;
#define KSRC(P, G, I) do { const int ci_ = (P) * 64 + lane; const int row_ = ci_ / 13; int ch_ = ci_ - row_ * 13; if (ch_ == 12) ch_ = 0; \
    if (ch_ < 8) { G = (const char*)(K8 + (size_t)row_ * 1024 + h * 128 + ch_ * 16); I = 65536u; } else { G = (const char*)(KR8 + (size_t)row_ * 64 + (ch_ - 8) * 16); I = 4096u; } } while (0)
    KSRC(widu, gKa, iKa); KSRC((widu < 5 ? widu + 8 : widu), gKb, iKb);
#undef KSRC
    const int vq0 = (widu + 3) & 7;
    unsigned voffV0, voffV1;
#define VSRC(Qp, V_) do { const int ci_ = (Qp) * 64 + lane; const int row_ = ci_ / 5; int ch_ = ci_ - row_ * 5; if (ch_ == 4) ch_ = 0; V_ = (unsigned)(row_ * S + ch_ * 16); } while (0)
    VSRC(vq0, voffV0); VSRC((vq0 < 2 ? vq0 + 8 : vq0), voffV1);
#undef VSRC
    const unsigned char* Vh = V8T + (size_t)h * 128 * S;
    LAS unsigned char* Kd = ldsl + LDS_K; LAS unsigned char* Vd = ldsl + LDS_V;
#define DMA_TILE(kt, kb, vs) do { const char* vt_ = (const char*)(Vh + (size_t)(kt) * 64); \
    __builtin_amdgcn_global_load_lds((const unsigned*)gKa, (LAS unsigned*)(Kd + (kb) * SHM_K + widu * 1024), 16, 0, 0); gKa += iKa; \
    if (widu < 5) { __builtin_amdgcn_global_load_lds((const unsigned*)gKb, (LAS unsigned*)(Kd + (kb) * SHM_K + (widu + 8) * 1024), 16, 0, 0); gKb += iKb; } \
    __builtin_amdgcn_global_load_lds((const unsigned*)(vt_ + voffV0), (LAS unsigned*)(Vd + (vs) * SHM_V + vq0 * 1024), 16, 0, 0); \
    if (vq0 < 2) __builtin_amdgcn_global_load_lds((const unsigned*)(vt_ + voffV1), (LAS unsigned*)(Vd + (vs) * SHM_V + (vq0 + 8) * 1024), 16, 0, 0); } while (0)
#define RESC(a_) do { if (__any((a_) != 1.f)) { if (hi == 0) al_l[r32] = (a_); asm volatile("s_waitcnt lgkmcnt(0)" ::: "memory"); \
    _Pragma("unroll") for (int d = 0; d < 5; ++d) _Pragma("unroll") for (int r = 0; r < 16; ++r) o[d][r] *= al_l[crow(r, hi)]; } } while (0)
#define LANDED() do { asm volatile("s_waitcnt vmcnt(0)" ::: "memory"); __syncthreads(); } while (0)
    f32x16 pA0, pA1, pB0, pB1; float alA, alB; v8i pf; const int NT = S / KVBLK;
    DMA_TILE(0, 0, 0); LANDED();
    DMA_TILE(1, 1, 1);
    qkt(pA0, pA1, K_lds, qf, negm, r32, hi); partialSM(pA0, pA1, m_reg, negm, alA);
    LANDED();
    int vprev = 0, vnext = 2;
#define VROT() do { vprev = (vprev == 2) ? 0 : vprev + 1; vnext = (vnext == 2) ? 0 : vnext + 1; } while (0)
    for (int j = 1; j + 1 < NT; j += 2) {
        DMA_TILE(j + 1, 0, vnext);
        qkt(pB0, pB1, K_lds + SHM_K, qf, negm, r32, hi);
        finishSM(pA0, pA1, pf);
        pv(o, V_lds + vprev * SHM_V, pf, r32, hi); partialSM(pB0, pB1, m_reg, negm, alB);
        RESC(alB); LANDED(); VROT();
        DMA_TILE(j + 2, 1, vnext);
        qkt(pA0, pA1, K_lds, qf, negm, r32, hi);
        finishSM(pB0, pB1, pf);
        pv(o, V_lds + vprev * SHM_V, pf, r32, hi); partialSM(pA0, pA1, m_reg, negm, alA);
        RESC(alA); LANDED(); VROT();
    }
    qkt(pB0, pB1, K_lds + SHM_K, qf, negm, r32, hi);
    finishSM(pA0, pA1, pf);
    pv(o, V_lds + vprev * SHM_V, pf, r32, hi); partialSM(pB0, pB1, m_reg, negm, alB);
    RESC(alB);
    finishSM(pB0, pB1, pf);
    pv(o, V_lds + ((vprev == 2) ? 0 : vprev + 1) * SHM_V, pf, r32, hi);
#undef VROT
#undef LANDED
#undef DMA_TILE
    { int tid2 = tid_in; asm volatile("" : "+v"(tid2));
      const int wid2 = tid2 >> 6, lane2 = tid2 & 63, r32b = lane2 & 31, hib = lane2 >> 5;
      float rli[16];
#pragma unroll
      for (int r = 0; r < 16; ++r) rli[r] = __builtin_amdgcn_rcpf(o[4][r]);
      bf16_t* Ow = O + (size_t)(q0 + wid2 * 32) * 1536 + h * 128;
#pragma unroll
      for (int r = 0; r < 16; ++r) { const int orow = crow(r, hib);
#pragma unroll
          for (int d0 = 0; d0 < 4; ++d0) { const float v = o[d0][r] * rli[r]; Ow[(size_t)orow * 1536 + d0 * 32 + r32b] = (bf16_t)(cvt_pk_bf16(v, v) & 0xffffu); } } }
    __syncthreads();
#undef RESC
#undef MFMA8
}
}

struct Args { const float* in[21]; float* out; unsigned char* ws; float inv_freq[32]; int grid; int pad; };
constexpr int LDS_BYTES = 147456;

enum { I_X = 0, I_EWIN, I_EQN, I_EWUQ, I_EKVN, I_EWUK, I_EWUV, I_EWOUT, I_OWIN, I_ONG, I_ONB, I_OWSP, I_OBSP, I_OWOUT, I_MLG, I_MLB, I_FWG, I_FWU, I_FWD, I_FLG, I_FLB };

struct Ctx { LAS unsigned char* lds; int tid, lane, wave, gw, NGW, G; };
__device__ __forceinline__ const float* inp(const Args& a, int idx) { (void)a; const Args* ap = launder_p((const Args*)(uintptr_t)__builtin_amdgcn_kernarg_segment_ptr()); return launder_p(ap->in[idx]); }


template <bool OUT_F16> __device__ __forceinline__ void tr_block(const float* src, int ld, bf16_t* dst, int ldt, LAS float* scr, int lane) {
    f32x4 v[8]; const int lr = lane >> 3, lc = 4 * (lane & 7);
#pragma unroll
    for (int i = 0; i < 8; ++i) v[i] = *(const f32x4*)(src + (size_t)(i * 8 + lr) * ld + lc);
#pragma unroll
    for (int i = 0; i < 8; ++i) { LAS float* p = scr + (i * 8 + lr) * 33 + lc; p[0] = v[i][0]; p[1] = v[i][1]; p[2] = v[i][2]; p[3] = v[i][3]; }
    asm volatile("s_waitcnt lgkmcnt(0)" ::: "memory");
    const int c = lane & 7;
#pragma unroll
    for (int j = 0; j < 4; ++j) { const int n = (lane >> 3) + 8 * j; const LAS float* s = scr + (8 * c) * 33 + n;
        u32x4 o; if constexpr (OUT_F16) { o.x = cvt_pk_f16(s[0 * 33], s[1 * 33]); o.y = cvt_pk_f16(s[2 * 33], s[3 * 33]); o.z = cvt_pk_f16(s[4 * 33], s[5 * 33]); o.w = cvt_pk_f16(s[6 * 33], s[7 * 33]); }
        else { o.x = cvt_pk_bf16(s[0 * 33], s[1 * 33]); o.y = cvt_pk_bf16(s[2 * 33], s[3 * 33]); o.z = cvt_pk_bf16(s[4 * 33], s[5 * 33]); o.w = cvt_pk_bf16(s[6 * 33], s[7 * 33]); }
        *(u32x4*)(dst + (size_t)n * ldt + 8 * c) = o; }
    asm volatile("s_waitcnt lgkmcnt(0)" ::: "memory");
}
template <int MODE, int HALFSEL, bool OUT_F16 = false>
__device__ __forceinline__ void tr_job(const Ctx& F, const float* src, int ld, int K, int ncb, bf16_t* dst, int ldt) {
    LAS float* scr = (LAS float*)(F.lds + F.wave * 16384);
    const int nitems = (K / 64) * ncb;
    for (int it = F.gw; it < nitems; it += F.NGW) { const int kb = it / ncb, nb = it % ncb; int scol, drow;
        if (MODE == 0) { scol = 32 * nb; drow = 32 * nb; }
        else if (MODE == 1) { drow = 32 * nb; if (drow < 1024) { scol = (drow >> 7) * 192 + (drow & 127); } else { const int x = drow - 1024, r = x >> 8, hf = (x >> 7) & 1, j = x & 127; scol = (4 * r + (j >> 5)) * 192 + 128 + hf * 32; } }
        else { scol = 32 * nb; drow = 256 * (scol >> 7) + HALFSEL * 128 + (scol & 127); }
        tr_block<OUT_F16>(src + (size_t)kb * 64 * ld + scol, ld, dst + (size_t)drow * ldt + kb * 64, ldt, scr, F.lane); }
}
__device__ __forceinline__ void convert_ffn(const Ctx& F, const Args& a, int layer) {
    unsigned char* wsl = launder_p(launder_p((const Args*)(uintptr_t)__builtin_amdgcn_kernarg_segment_ptr())->ws); bf16_t* gu = (bf16_t*)(wsl + WS_WFFN + WF_GU); bf16_t* dn = (bf16_t*)(wsl + WS_WFFN + WF_DN);
    tr_job<2, 0, true>(F, inp(a, I_FWG) + (size_t)layer * DM * DFF, DFF, DM, DFF / 32, gu, DM);
    tr_job<2, 1, true>(F, inp(a, I_FWU) + (size_t)layer * DM * DFF, DFF, DM, DFF / 32, gu, DM);
    tr_job<0, 0>(F, inp(a, I_FWD) + (size_t)layer * DFF * DM, DM, DFF, DM / 32, dn, DFF);
}
__device__ __forceinline__ void convert_odd(const Ctx& F, const Args& a, int i) {
    unsigned char* w = launder_p(launder_p((const Args*)(uintptr_t)__builtin_amdgcn_kernarg_segment_ptr())->ws) + WS_WMIX;
    tr_job<0, 0, true>(F, inp(a, I_OWIN) + (size_t)i * DM * 4096, 4096, DM, 4096 / 32, (bf16_t*)(w + WO_IN), DM);
    tr_job<0, 0>(F, inp(a, I_OWOUT) + (size_t)i * 2048 * DM, DM, 2048, DM / 32, (bf16_t*)(w + WO_OUT), 2048);
    const float* wsp = inp(a, I_OWSP) + (size_t)i * 8 * 128 * 128; bf16_t* d = (bf16_t*)(w + WO_SP);
    for (int e = (F.gw * 64 + F.lane) * 4; e < 8 * 128 * 128; e += F.NGW * 64 * 4) { const f32x4 v = *(const f32x4*)(wsp + e); u32x2 o; o.x = cvt_pk_bf16(v[0], v[1]); o.y = cvt_pk_bf16(v[2], v[3]); *(u32x2*)(d + e) = o; }
}
__device__ __forceinline__ void convert_even(const Ctx& F, const Args& a, int i) {
    unsigned char* w = launder_p(launder_p((const Args*)(uintptr_t)__builtin_amdgcn_kernarg_segment_ptr())->ws) + WS_WMIX;
    const float* win = inp(a, I_EWIN) + (size_t)i * DM * 1216;
    tr_job<0, 0, true>(F, win, 1216, DM, 704 / 32, (bf16_t*)(w + WE_INN), DM);
    { bf16_t* z = (bf16_t*)(w + WE_INN) + (size_t)704 * DM;
      for (int e = (F.gw * 64 + F.lane) * 8; e < 64 * DM; e += F.NGW * 64 * 8) *(u32x4*)(z + e) = (u32x4){0u, 0u, 0u, 0u}; }
    tr_job<1, 0>(F, inp(a, I_EWUQ) + (size_t)i * 384 * 1536, 1536, 384, 1536 / 32, (bf16_t*)(w + WE_Q), 384);
    tr_job<0, 0>(F, inp(a, I_EWUK) + (size_t)i * 256 * 1024, 1024, 256, 1024 / 32, (bf16_t*)(w + WE_KV), 256);
    tr_job<0, 0>(F, inp(a, I_EWUV) + (size_t)i * 256 * 1024, 1024, 256, 1024 / 32, (bf16_t*)(w + WE_KV) + (size_t)1024 * 256, 256);
    const float* wout = inp(a, I_EWOUT) + (size_t)i * 1536 * DM;
    tr_job<0, 0>(F, wout, DM, 1536, DM / 32, (bf16_t*)(w + WE_OUTA), 1536);
    LAS float* tab = (LAS float*)(F.lds + 131072);
    bf16_t* wf = (bf16_t*)(w + WE_INF);
    for (int t = F.gw; t < 16 * 512; t += F.NGW) { const int kblk = t >> 9, gj = t & 511, g = gj >> 7, j = gj & 127; const int k = kblk * 64 + F.lane;
        const float* wr_ = win + (size_t)k * 1216 + 704 + g * 128; float p = 0.f, q = 0.f;
#pragma unroll 4
        for (int ch = 0; ch < 128; ch += 4) { const f32x4 v = *(const f32x4*)(wr_ + ch);
#pragma unroll
            for (int e = 0; e < 4; ++e) { const int idx = ((ch + e) * j) & 127; p = fmaf(v[e], tab[idx], p); q = fmaf(v[e], tab[128 + idx], q); } }
        wf[(size_t)(gj * 2) * DM + k] = (bf16_t)(cvt_pk_f16(p, p) & 0xffffu); wf[(size_t)(gj * 2 + 1) * DM + k] = (bf16_t)(cvt_pk_f16(q, q) & 0xffffu); }
}
__device__ __forceinline__ void ln_rows(const Ctx& F, float* x, bf16_t* xb, const float* g, const float* b) {
    f32x4 gv[4], bv[4];
#pragma unroll
    for (int j = 0; j < 4; ++j) { gv[j] = *(const f32x4*)(g + 4 * F.lane + 256 * j); bv[j] = *(const f32x4*)(b + 4 * F.lane + 256 * j); }
    for (int m = F.gw; m < S; m += F.NGW) { float* xr = x + (size_t)m * DM + 4 * F.lane; f32x4 v[4]; float s = 0.f;
#pragma unroll
        for (int j = 0; j < 4; ++j) { v[j] = *(const f32x4*)(xr + 256 * j); s += (v[j][0] + v[j][1]) + (v[j][2] + v[j][3]); }
        const float mean = wave_sum(s, F.lane) * (1.f / DM); float s2 = 0.f;
#pragma unroll
        for (int j = 0; j < 4; ++j) { v[j] = v[j] - mean; s2 += (v[j][0] * v[j][0] + v[j][1] * v[j][1]) + (v[j][2] * v[j][2] + v[j][3] * v[j][3]); }
        const float rstd = 1.f / sqrtf(wave_sum(s2, F.lane) * (1.f / DM) + LN_EPS);
        bf16_t* br = xb + (size_t)m * DM + 4 * F.lane;
#pragma unroll
        for (int j = 0; j < 4; ++j) { const f32x4 o = v[j] * rstd * gv[j] + bv[j]; *(f32x4*)(xr + 256 * j) = o; u32x2 w; w.x = cvt_pk_bf16(o[0], o[1]); w.y = cvt_pk_bf16(o[2], o[3]); *(u32x2*)(br + 256 * j) = w; } }
}

#define PHASE_BEGIN() \
    Ctx F; { const int b_ = launder_i(blockIdx.x); \
      F.lds = (LAS unsigned char*)lds_raw; F.lane = hw_lane(); F.wave = hw_wave(F.lds); F.tid = F.wave * 64 + F.lane; F.G = 0; F.gw = b_ * NW + F.wave; F.NGW = 0; } \
    const int bx = (F.gw - F.wave) / NW; (void)bx; \
    const Args* ap_ = launder_p((const Args*)(uintptr_t)__builtin_amdgcn_kernarg_segment_ptr()); unsigned char* ws = launder_p(ap_->ws); F.G = launder_i(ap_->grid); F.NGW = F.G * NW; unsigned char* act = ws + WS_ACT; (void)act; \
    float* xres = launder_p(ap_->out); bf16_t* xb = (bf16_t*)(ws + WS_XB); (void)xb; (void)xres; \
    unsigned char* w = ws + WS_WMIX; (void)w; \
    float* ropeC = (float*)(ws + WS_ROPEC); float* ropeS = (float*)(ws + WS_ROPES); f32x2* tw = (f32x2*)(ws + WS_TW); bf16_t* fst = (bf16_t*)(ws + WS_FST); (void)ropeC; (void)ropeS; (void)tw; (void)fst;


#define XB_TMO      128
#define XB_XCNT(j)  (256  + 64 * (j))
#define XB_XSUB(j)  (1280 + 64 * (j))
#define XB_XGEN(j)  (2304 + 64 * (j))
#define XB_TOP      3328
#define XB_TOPGEN   3392
#define XB_SPIN_CAP (1u << 22)
constexpr size_t WS_BAR = 16384, WS_LNCNT = 65536, WS_LNX = 262144, WS_CLNCNT = 196608, WS_CLNX = 5 * MiB + 512 * 1024;
constexpr int XB_LDS_OFF = 147456 - 512;
__device__ __forceinline__ unsigned xb_ld(unsigned* p)              { return __hip_atomic_load(p, __ATOMIC_RELAXED, __HIP_MEMORY_SCOPE_AGENT); }
__device__ __forceinline__ unsigned xb_add(unsigned* p, unsigned v) { return __hip_atomic_fetch_add(p, v, __ATOMIC_RELAXED, __HIP_MEMORY_SCOPE_AGENT); }
__device__ __forceinline__ unsigned xb_xcc_id() { return (unsigned)__builtin_amdgcn_s_getreg((3 << 11) | 20) & 0xFu; }
#define XB_SPIN(cond, bar) do { unsigned _sp = 0; while (cond) { __builtin_amdgcn_s_sleep(1); \
    if ((++_sp & 255u) == 0u) { if (xb_ld(&(bar)[XB_TMO])) break; if (_sp > XB_SPIN_CAP) { atomicAdd(&(bar)[XB_TMO], 1u); break; } } } } while (0)
__device__ __forceinline__ void xcd_barrier_complete(unsigned* bar, unsigned x, unsigned G, unsigned& nloc, unsigned& nx) {
    unsigned sum, cnt, mine, sp = 0u;
    for (;;) {
        sum = 0u; cnt = 0u; mine = 0u;
#pragma unroll
        for (unsigned j = 0; j < 16; ++j) { const unsigned c = xb_ld(&bar[XB_XCNT(j)]); sum += c; cnt += (c > 0u) ? 1u : 0u; mine = (j == x) ? c : mine; }
        if (sum == G) break;
        __builtin_amdgcn_s_sleep(1);
        if ((++sp & 255u) == 0u) { if (xb_ld(&bar[XB_TMO])) break; if (sp > XB_SPIN_CAP) { atomicAdd(&bar[XB_TMO], 1u); break; } }
    }
    nloc = mine > 0u ? mine : 1u; nx = cnt > 0u ? cnt : 1u;
}
__device__ __forceinline__ void xcd_barrier(unsigned char* wsb, LAS unsigned char* lds, int tid, unsigned G) {
    asm volatile("s_waitcnt vmcnt(0)" ::: "memory");
    __syncthreads();
    if (tid == 0) {
        unsigned* bar = (unsigned*)(wsb + WS_BAR); volatile LAS unsigned* st = (volatile LAS unsigned*)(lds + XB_LDS_OFF);
        const unsigned x = xb_xcc_id();
        __builtin_amdgcn_s_waitcnt(0);
        unsigned nloc = st[0], nx = st[1];
        if (nloc == 0u) { xcd_barrier_complete(bar, x, G, nloc, nx); st[0] = nloc; st[1] = nx; }
        const unsigned old = xb_add(&bar[XB_XSUB(x)], 1u);
        const unsigned gen = old / nloc;
        if (old + 1u == (gen + 1u) * nloc) {
            __builtin_amdgcn_fence(__ATOMIC_RELEASE, "agent");
            asm volatile("s_waitcnt vmcnt(0)" ::: "memory");
            const unsigned og = xb_add(&bar[XB_TOP], 1u);
            const unsigned tg = og / nx;
            if (og + 1u == (tg + 1u) * nx) xb_add(&bar[XB_TOPGEN], 1u);
            else XB_SPIN(xb_ld(&bar[XB_TOPGEN]) == tg, bar);
            __builtin_amdgcn_fence(__ATOMIC_ACQUIRE, "agent");
            xb_add(&bar[XB_XGEN(x)], 1u);
            asm volatile("s_waitcnt vmcnt(0)" ::: "memory");
        } else {
            XB_SPIN(xb_ld(&bar[XB_XGEN(x)]) == gen, bar);
            __builtin_amdgcn_fence(__ATOMIC_ACQUIRE, "agent");
            asm volatile("s_waitcnt vmcnt(0)" ::: "memory");
        }
    }
    __syncthreads();
}
#define GSYNC() do { PHASE_BEGIN(); xcd_barrier(ws, F.lds, F.tid, (unsigned)F.G); } while (0)

#ifdef PROBE_BUILD
__device__ __forceinline__ float blk_sum(float v, LAS float* red, int tid) { __syncthreads(); red[tid] = v; __syncthreads(); for (int o = 256; o > 0; o >>= 1) { if (tid < o) red[tid] += red[tid + o]; __syncthreads(); } const float r = red[0]; __syncthreads(); return r; }
__device__ __forceinline__ float blk_max(float v, LAS float* red, int tid) { __syncthreads(); red[tid] = v; __syncthreads(); for (int o = 256; o > 0; o >>= 1) { if (tid < o) red[tid] = fmaxf(red[tid], red[tid + o]); __syncthreads(); } const float r = red[0]; __syncthreads(); return r; }
__device__ __forceinline__ void probe_flag(unsigned char* ws, float e, float n, unsigned bit, int tid) { if (tid == 0 && !(e <= 4e-4f * n)) atomicOr((unsigned*)ws, bit); }
__device__ __forceinline__ void probe_a(const Ctx& F, const Args& a, unsigned char* ws, int bx) {
    if (bx >= 8) return;
    const int tid = F.tid, s = (bx * 2053 + 77) & (S - 1);
    unsigned char* act = ws + WS_ACT; LAS float* red = (LAS float*)F.lds; LAS float* hrow = red + 512; LAS float* sc = hrow + 768;
    const bf16_t* xb = (const bf16_t*)(ws + WS_XB); const float* win = inp(a, I_EWIN); const float* hb = (const float*)(act + A_HBUF);
    float e = 0.f, n = 0.f;
    for (int t = tid; t < 704; t += 512) { float acc = 0.f; for (int k = 0; k < 1024; ++k) acc += bf2f(xb[(size_t)s * 1024 + k]) * win[(size_t)k * 1216 + t]; hrow[t] = acc; const float g = hb[(size_t)s * 768 + t]; e += (g - acc) * (g - acc); n += acc * acc; }
    e = blk_sum(e, red, tid); n = blk_sum(n, red, tid); probe_flag(ws, e, n, 1u, tid);
    if (tid == 0) { float q = 0.f, kv = 0.f; for (int k = 0; k < 384; ++k) q += hrow[k] * hrow[k]; for (int k = 384; k < 640; ++k) kv += hrow[k] * hrow[k]; sc[0] = 1.f / sqrtf(q / 384.f + RMS_EPS); sc[1] = 1.f / sqrtf(kv / 256.f + RMS_EPS); }
    __syncthreads();
    const float* qn = inp(a, I_EQN); const float* kvn = inp(a, I_EKVN); const bf16_t* cqn = (const bf16_t*)(act + A_CQN); const bf16_t* ckvn = (const bf16_t*)(act + A_CKVN);
    e = 0.f; n = 0.f;
    for (int t = tid; t < 640; t += 512) { float ref, g; if (t < 384) { ref = hrow[t] * sc[0] * qn[t]; g = bf2f(cqn[(size_t)s * 384 + t]); } else { ref = hrow[t] * sc[1] * kvn[t - 384]; g = bf2f(ckvn[(size_t)s * 256 + t - 384]); } e += (g - ref) * (g - ref); n += ref * ref; }
    e = blk_sum(e, red, tid); n = blk_sum(n, red, tid); probe_flag(ws, e, n, 2u, tid);
    const Args* ap = launder_p((const Args*)(uintptr_t)__builtin_amdgcn_kernarg_segment_ptr()); const bf16_t* kr = (const bf16_t*)(act + A_KR);
    e = 0.f; n = 0.f;
    if (tid < 64) { const int dd = tid & 31; const float ang = (float)s * ap->inv_freq[dd]; const float c = __cosf(ang), sn = __sinf(ang);
        const float ref = (tid < 32) ? hrow[640 + tid] * c - hrow[640 + tid + 32] * sn : hrow[640 + tid - 32] * sn + hrow[640 + tid] * c; const float g = bf2f(kr[(size_t)s * 64 + tid]); e = (g - ref) * (g - ref); n = ref * ref; }
    e = blk_sum(e, red, tid); n = blk_sum(n, red, tid); probe_flag(ws, e, n, 4u, tid);
}
__device__ __forceinline__ void probe_b(const Ctx& F, const Args& a, unsigned char* ws, int bx) {
    if (bx >= 8) return;
    const int tid = F.tid, s = (bx * 2053 + 77) & (S - 1), h = bx;
    unsigned char* act = ws + WS_ACT; LAS float* red = (LAS float*)F.lds; LAS float* qraw = red + 512; LAS float* part = qraw + 256; LAS float* p = part + 512;
    const bf16_t* cqn = (const bf16_t*)(act + A_CQN); const bf16_t* ckvn = (const bf16_t*)(act + A_CKVN); const bf16_t* Q = (const bf16_t*)(act + A_Q); const bf16_t* KV = (const bf16_t*)(act + A_KV); const bf16_t* KR = (const bf16_t*)(act + A_KR);
    const float* wuq = inp(a, I_EWUQ); const float* wuk = inp(a, I_EWUK); const float* wuv = inp(a, I_EWUV);
    const Args* ap = launder_p((const Args*)(uintptr_t)__builtin_amdgcn_kernarg_segment_ptr());
    if (tid < 192) { float acc = 0.f; for (int k = 0; k < 384; ++k) acc += bf2f(cqn[(size_t)s * 384 + k]) * wuq[(size_t)k * 1536 + h * 192 + tid]; qraw[tid] = acc; }
    __syncthreads();
    float e = 0.f, n = 0.f;
    if (tid < 192) { float ref = qraw[tid]; if (tid >= 128) { const int dd = (tid - 128) & 31; const float ang = (float)s * ap->inv_freq[dd]; const float c = __cosf(ang), sn = __sinf(ang);
            ref = (tid < 160) ? qraw[tid] * c - qraw[tid + 32] * sn : qraw[tid - 32] * sn + qraw[tid] * c; }
        const float g = bf2f(Q[((size_t)h * S + s) * 192 + tid]); e = (g - ref) * (g - ref); n = ref * ref; }
    e = blk_sum(e, red, tid); n = blk_sum(n, red, tid); probe_flag(ws, e, n, 8u, tid);
    e = 0.f; n = 0.f;
    if (tid < 256) { const int d = tid & 127; const float* wm = (tid < 128) ? wuk : wuv; float acc = 0.f; for (int k = 0; k < 256; ++k) acc += bf2f(ckvn[(size_t)s * 256 + k]) * wm[(size_t)k * 1024 + h * 128 + d];
        const float g = bf2f(KV[((size_t)((tid < 128 ? 0 : 8) + h) * S + s) * 128 + d]); e = (g - acc) * (g - acc); n = acc * acc; }
    e = blk_sum(e, red, tid); n = blk_sum(n, red, tid); probe_flag(ws, e, n, 16u, tid);
    if (tid < 192) qraw[tid] = bf2f(Q[((size_t)h * S + s) * 192 + tid]);
    __syncthreads();
    float mx = -1e30f;
    for (int i = 0; i < 32; ++i) { const int j = tid + 512 * i; float acc = 0.f; for (int d = 0; d < 128; ++d) acc += qraw[d] * bf2f(KV[((size_t)h * S + j) * 128 + d]); for (int d = 0; d < 64; ++d) acc += qraw[128 + d] * bf2f(KR[(size_t)j * 64 + d]); p[j] = acc; mx = fmaxf(mx, acc); }
    mx = blk_max(mx, red, tid);
    float sm = 0.f;
    for (int i = 0; i < 32; ++i) { const int j = tid + 512 * i; const float v = __expf((p[j] - mx) * 0.07216878364870323f); p[j] = v; sm += v; }
    sm = blk_sum(sm, red, tid);
    { const int d = tid & 127, pt = tid >> 7; float acc = 0.f; for (int j = pt * 4096; j < (pt + 1) * 4096; ++j) acc += p[j] * bf2f(KV[((size_t)(8 + h) * S + j) * 128 + d]); part[tid] = acc; }
    __syncthreads();
    e = 0.f; n = 0.f;
    if (tid < 128) { const float ref = (part[tid] + part[128 + tid] + part[256 + tid] + part[384 + tid]) / sm; const float g = bf2f(((const bf16_t*)(act + A_ATTNO))[(size_t)s * 1024 + h * 128 + tid]); e = (g - ref) * (g - ref); n = ref * ref; }
    e = blk_sum(e, red, tid); n = blk_sum(n, red, tid); probe_flag(ws, e, n, 32u, tid);
}
#endif

template <int layer> __device__ __forceinline__ void layer_body(const Args& a, unsigned char* lds_raw, cg::grid_group& grid) {
        const int li = layer >> 1;
        if (layer > 0) { PHASE_BEGIN(); convert_ffn(F, a, layer); __syncthreads(); }
        if ((layer & 1) == 0) {
            { PHASE_BEGIN();
              pg8::Gemm g{DM, DM, 128u * DM * 2u, 128u * DM * 2u, 1, DM}; pg8::StaticOrder So; So.init(S / 256, 3, F.G, bx, xres, (size_t)256 * DM * 2, w + WE_INN, (size_t)256 * DM * 2);
              pg8::EpiF16 E{(_Float16*)(act + A_HBUF), 768}; pg8::gemm_phase<true>(F.lds, g, So, E, F.tid); }
            { PHASE_BEGIN();
              pg8::Gemm g{DM, DM, 128u * DM * 2u, (unsigned)DM * 2u, 128, DM}; pg8::StaticOrder So; So.init(4, 64, F.G, bx, w + WE_INF, (size_t)256 * DM * 2, xres, (size_t)2 * DM * 2);
              pg8::EpiBf16<0> E{(bf16_t*)(act + A_ZT), (size_t)S}; pg8::gemm_phase<true>(F.lds, g, So, E, F.tid); }
            GSYNC();
            { PHASE_BEGIN();
              const _Float16* hb = (const _Float16*)(act + A_HBUF); bf16_t* cqn = (bf16_t*)(act + A_CQN); bf16_t* ckvn = (bf16_t*)(act + A_CKVN); bf16_t* kr = (bf16_t*)(act + A_KR);
              const float* qn = inp(a, I_EQN) + li * 384; const float* kvn = inp(a, I_EKVN) + li * 256;
              typedef float f32x8 __attribute__((ext_vector_type(8)));
              const int L = F.lane, l = L & 31, hf = L >> 5;
              const f32x8 g0 = *(const f32x8*)(qn + 8 * l);
              const f32x8 g1 = (l < 16) ? *(const f32x8*)(qn + 256 + 8 * l) : *(const f32x8*)(kvn + 8 * l - 128);
              const f32x8 g2 = (l < 16) ? *(const f32x8*)(kvn + 128 + 8 * l) : (f32x8){0.f, 0.f, 0.f, 0.f, 0.f, 0.f, 0.f, 0.f};
              for (int m0 = 2 * F.gw; m0 < S; m0 += 2 * F.NGW) { const int m = m0 + hf; const _Float16* hr = hb + (size_t)m * 768 + 8 * l;
                  const f32x8 v0 = __builtin_convertvector(*(const h16x8*)hr, f32x8), v1 = __builtin_convertvector(*(const h16x8*)(hr + 256), f32x8), v2 = __builtin_convertvector(*(const h16x8*)(hr + 512), f32x8);
                  float q0 = 0.f, q1 = 0.f, q2 = 0.f;
#pragma unroll
                  for (int e = 0; e < 8; ++e) { q0 += v0[e] * v0[e]; q1 += v1[e] * v1[e]; q2 += v2[e] * v2[e]; }
                  float sq = q0 + (l < 16 ? q1 : 0.f), skv = (l >= 16 ? q1 : 0.f) + (l < 16 ? q2 : 0.f);
#pragma unroll
                  for (int o = 1; o < 32; o <<= 1) { sq += shfl_xor_l(sq, o, L); skv += shfl_xor_l(skv, o, L); }
                  const float rq = 1.f / sqrtf(sq * (1.f / 384.f) + RMS_EPS), rkv = 1.f / sqrtf(skv * (1.f / 256.f) + RMS_EPS);
#define PK8(V) (u32x4){cvt_pk_bf16((V)[0], (V)[1]), cvt_pk_bf16((V)[2], (V)[3]), cvt_pk_bf16((V)[4], (V)[5]), cvt_pk_bf16((V)[6], (V)[7])}
                  { const f32x8 o = v0 * rq * g0; *(u32x4*)(cqn + (size_t)m * 384 + 8 * l) = PK8(o); }
                  { const f32x8 o = v1 * (l < 16 ? rq : rkv) * g1;
                    if (l < 16) *(u32x4*)(cqn + (size_t)m * 384 + 256 + 8 * l) = PK8(o); else *(u32x4*)(ckvn + (size_t)m * 256 + 8 * l - 128) = PK8(o); }
                  { const f32x8 o = v2 * rkv * g2; if (l < 16) *(u32x4*)(ckvn + (size_t)m * 256 + 128 + 8 * l) = PK8(o); }
#undef PK8
                  f32x8 pv;
#pragma unroll
                  for (int e = 0; e < 8; ++e) pv[e] = shfl_xor_l(v2[e], 4, L);
                  if (l >= 16 && l < 24) { const int d = 8 * (l - 16), dd = d & 31;
                      const f32x8 cc = *(const f32x8*)(ropeC + (size_t)m * 32 + dd), ss = *(const f32x8*)(ropeS + (size_t)m * 32 + dd);
                      const f32x8 o = (d < 32) ? (v2 * cc - pv * ss) : (pv * ss + v2 * cc);
                      *(u32x2*)((unsigned char*)kr + (size_t)m * 64 + d) = (u32x2){pk4_fp8((f32x4){o[0], o[1], o[2], o[3]}), pk4_fp8((f32x4){o[4], o[5], o[6], o[7]})}; } }
            }
            { PHASE_BEGIN();
              pg8::Gemm g{128, 128, 128u * 128u * 2u, 128u * 128u * 2u, 1, 128}; pg8::StaticOrder So; So.init(1, 512, F.G, bx, fst, 0, act + A_ZT, (size_t)256 * 128 * 2);
              pg8::EpiF1 E{(bf16_t*)(act + A_AP), tw}; pg8::gemm_phase(F.lds, g, So, E, F.tid); }
            GSYNC();
#ifdef PROBE_BUILD
            if (layer == 0) { { PHASE_BEGIN(); probe_a(F, a, ws, bx); } GSYNC(); }
#endif
            { PHASE_BEGIN();
              pg8::Gemm g{128, 128, 128u * 128u * 2u, 128u * 128u * 2u, 1, 128}; pg8::StaticOrder So; So.init(1, 512, F.G, bx, fst, 0, act + A_AP, (size_t)256 * 128 * 2);
              pg8::EpiF2 E{(bf16_t*)(ws + WS_MIX)}; pg8::gemm_phase(F.lds, g, So, E, F.tid); }
            { PHASE_BEGIN();
              pg8::Gemm g{384, 384, 128u * 384u * 2u, 128u * 384u * 2u, 1, 384}; pg8::StaticOrder So; So.init(S / 256, 6, F.G, bx, act + A_CQN, (size_t)256 * 384 * 2, w + WE_Q, (size_t)256 * 384 * 2);
              pg8::EpiQ E{(unsigned char*)(act + A_Q), ropeC, ropeS}; pg8::gemm_phase(F.lds, g, So, E, F.tid); }
            { PHASE_BEGIN();
              pg8::Gemm g{256, 256, 128u * 256u * 2u, 128u * 256u * 2u, 1, 256}; pg8::StaticOrder So; So.init(S / 256, 4, F.G, bx, act + A_CKVN, (size_t)256 * 256 * 2, w + WE_KV, (size_t)256 * 256 * 2);
              pg8::EpiFp8 E{(unsigned char*)(act + A_K8), (size_t)1024}; pg8::gemm_phase(F.lds, g, So, E, F.tid); }
            { PHASE_BEGIN();
              pg8::Gemm g{256, 256, 128u * 256u * 2u, 128u * 256u * 2u, 1, 256}; pg8::StaticOrder So; So.init(4, S / 256, F.G, bx, w + WE_KV + (size_t)1024 * 256 * 2, (size_t)256 * 256 * 2, act + A_CKVN, (size_t)256 * 256 * 2);
              pg8::EpiFp8 E{(unsigned char*)(act + A_V8T), (size_t)S}; pg8::gemm_phase(F.lds, g, So, E, F.tid); }
            GSYNC();
            { PHASE_BEGIN();
              const int h = bx & 7;
              for (int qb = bx >> 3; qb < 64; qb += (F.G >> 3))
                  att8::attn_unit(h, qb * 256, (const unsigned char*)(act + A_Q), (const unsigned char*)(act + A_K8), (const unsigned char*)(act + A_KR), (const unsigned char*)(act + A_V8T), (bf16_t*)(ws + WS_MIX), (char*)lds_raw, F.lds, F.tid); }
            GSYNC();
#ifdef PROBE_BUILD
            if (layer == 0) { { PHASE_BEGIN(); probe_b(F, a, ws, bx); } GSYNC(); }
#endif
            { PHASE_BEGIN();
              pg8::Gemm g{1536, 1536, 128u * 1536u * 2u, 128u * 1536u * 2u, 1, 1536}; pg8::StaticOrder So; So.init(S / 256, 4, F.G, bx, ws + WS_MIX, (size_t)256 * 1536 * 2, w + WE_OUTA, (size_t)256 * 1536 * 2);
              if constexpr (layer == 0) { pg8::EpiLn<false, true, true> E{nullptr, (_Float16*)(act + A_XHM), nullptr, inp(a, I_X), inp(a, I_MLG) + layer * DM, inp(a, I_MLB) + layer * DM, DN_ALPHA, (unsigned long long*)(ws + WS_LNX), (unsigned*)(ws + WS_LNCNT) + (layer * 2) * 4096};
                  pg8::gemm_phase(F.lds, g, So, E, F.tid); }
              else { pg8::EpiLn<false, true, false> E{(const _Float16*)xres, (_Float16*)(act + A_XHM), nullptr, nullptr, inp(a, I_MLG) + layer * DM, inp(a, I_MLB) + layer * DM, DN_ALPHA, (unsigned long long*)(ws + WS_LNX), (unsigned*)(ws + WS_LNCNT) + (layer * 2) * 4096};
                  pg8::gemm_phase(F.lds, g, So, E, F.tid); } }
            GSYNC();
        } else {
            { PHASE_BEGIN();
              pg8::Gemm g{DM, DM, 128u * DM * 2u, 128u * DM * 2u, 1, DM}; pg8::StaticOrder So; So.init(S / 256, 8, F.G, bx, xres, (size_t)256 * DM * 2, w + WO_IN, (size_t)256 * DM * 2);
              pg8::EpiBf16<1> E{(bf16_t*)(act + A_U), (size_t)2048}; pg8::gemm_phase<true>(F.lds, g, So, E, F.tid); }
            { PHASE_BEGIN();
              pg8::Gemm g{DM, DM, 128u * DM * 2u, 128u * DM * 2u, 1, DM}; pg8::StaticOrder So; So.init(8, S / 256, F.G, bx, w + WO_IN + (size_t)2048 * DM * 2, (size_t)256 * DM * 2, xres, (size_t)256 * DM * 2);
              pg8::EpiGeluColLn E{(bf16_t*)(act + A_VT), (size_t)S, inp(a, I_ONG) + li * 2048, inp(a, I_ONB) + li * 2048, (unsigned long long*)(ws + WS_CLNX), (unsigned*)(ws + WS_CLNCNT) + li * 4096, F.lds + 132096};
              pg8::gemm_phase<true>(F.lds, g, So, E, F.tid); }
            GSYNC();
#if 0
            { PHASE_BEGIN();
              bf16_t* vT = (bf16_t*)(act + A_VT); const float* ng = inp(a, I_ONG) + li * 2048; const float* nb = inp(a, I_ONB) + li * 2048;
              LAS float* psum = (LAS float*)F.lds; LAS float* psq = psum + 64 * 64; LAS float* stat = psq + 64 * 64;
              const int oct = F.tid & 7, strip = F.tid >> 3;
              for (int un = bx; un < S / 64; un += F.G) { const int s0 = un * 64 + oct * 8;
                  float sm[8], sq[8];
#pragma unroll
                  for (int e = 0; e < 8; ++e) { sm[e] = 0.f; sq[e] = 0.f; }
                  for (int i = 0; i < 32; ++i) { const int c = strip + 64 * i; const u32x4 r = *(const u32x4*)(vT + (size_t)c * S + s0);
#pragma unroll
                      for (int e = 0; e < 4; ++e) { const unsigned wv = r[e]; const float lo = __uint_as_float(wv << 16), hi = __uint_as_float(wv & 0xffff0000u);
                          sm[2 * e] += lo; sq[2 * e] += lo * lo; sm[2 * e + 1] += hi; sq[2 * e + 1] += hi * hi; } }
#pragma unroll
                  for (int e = 0; e < 8; ++e) { psum[strip * 64 + oct * 8 + e] = sm[e]; psq[strip * 64 + oct * 8 + e] = sq[e]; }
                  __syncthreads();
                  if (F.tid < 64) { float ts = 0.f, tq = 0.f; for (int k = 0; k < 64; ++k) { ts += psum[k * 64 + F.tid]; tq += psq[k * 64 + F.tid]; }
                      const float mean = ts * (1.f / 2048.f); const float var = fmaxf(tq * (1.f / 2048.f) - mean * mean, 0.f); stat[F.tid] = mean; stat[64 + F.tid] = 1.f / sqrtf(var + LN_EPS); }
                  __syncthreads();
                  float mu[8], rs[8];
#pragma unroll
                  for (int e = 0; e < 8; ++e) { mu[e] = stat[oct * 8 + e]; rs[e] = stat[64 + oct * 8 + e]; }
                  for (int i = 0; i < 32; ++i) { const int c = strip + 64 * i; u32x4* p = (u32x4*)(vT + (size_t)c * S + s0); const u32x4 r = *p; const float gg = ng[c], bb = nb[c];
                      u32x4 ov;
#pragma unroll
                      for (int e = 0; e < 4; ++e) { const unsigned wv = r[e]; const float lo = __uint_as_float(wv << 16), hi = __uint_as_float(wv & 0xffff0000u);
                          ov[e] = cvt_pk_bf16((lo - mu[2 * e]) * rs[2 * e] * gg + bb, (hi - mu[2 * e + 1]) * rs[2 * e + 1] * gg + bb); }
                      *p = ov; }
                  __syncthreads(); }
            }
            GSYNC();
#endif
            { PHASE_BEGIN();
              pg8::Gemm g{128, S, 128u * 128u * 2u, 256u * (unsigned)S * 2u, 1, 128}; pg8::SpatialOrder So{F.G, bx, (const char*)(w + WO_SP), (const char*)(act + A_VT), S};
              pg8::EpiSpatial E{(bf16_t*)(act + A_U), inp(a, I_OBSP) + li * 8 * 128}; pg8::gemm_phase(F.lds, g, So, E, F.tid); }
            GSYNC();
            { PHASE_BEGIN();
              pg8::Gemm g{2048, 2048, 128u * 2048u * 2u, 128u * 2048u * 2u, 1, 2048}; pg8::StaticOrder So; So.init(S / 256, 4, F.G, bx, act + A_U, (size_t)256 * 2048 * 2, w + WO_OUT, (size_t)256 * 2048 * 2);
              pg8::EpiLn<false, true> E{(const _Float16*)xres, (_Float16*)(act + A_XHM), nullptr, nullptr, inp(a, I_MLG) + layer * DM, inp(a, I_MLB) + layer * DM, DN_ALPHA, (unsigned long long*)(ws + WS_LNX), (unsigned*)(ws + WS_LNCNT) + (layer * 2) * 4096};
              pg8::gemm_phase(F.lds, g, So, E, F.tid); }
            GSYNC();
        }
        { PHASE_BEGIN();
          pg8::Gemm g{DM, DM, 128u * DM * 2u, 128u * DM * 2u, 1, DM}; pg8::StaticOrder So; So.init(S / 256, 22, F.G, bx, act + A_XHM, (size_t)256 * DM * 2, ws + WS_WFFN + WF_GU, (size_t)256 * DM * 2);
          pg8::EpiSwiglu E{(bf16_t*)(act + A_HMID), DFF}; pg8::gemm_phase<true>(F.lds, g, So, E, F.tid); }
        if (layer + 1 < 4) { PHASE_BEGIN();
            if (bx >= (F.G >> 1)) { F.gw = (bx - (F.G >> 1)) * NW + F.wave; F.NGW = (F.G >> 1) * NW;
                if (((layer + 1) & 1) == 0) { LAS float* tab = (LAS float*)(F.lds + 131072); if (F.tid < 256) tab[F.tid] = ((const float*)(ws + WS_FTAB))[F.tid]; __syncthreads(); convert_even(F, a, (layer + 1) >> 1); }
                else convert_odd(F, a, (layer + 1) >> 1);
                __syncthreads(); } }
        GSYNC();
        { PHASE_BEGIN();
          pg8::Gemm g{DFF, DFF, 128u * DFF * 2u, 128u * DFF * 2u, 1, DFF}; pg8::StaticOrder So; So.init(S / 256, 4, F.G, bx, act + A_HMID, (size_t)256 * DFF * 2, ws + WS_WFFN + WF_DN, (size_t)256 * DFF * 2);
          pg8::EpiLn<(layer == 3), (layer != 3)> E{(const _Float16*)(act + A_XHM), (_Float16*)xres, xres, nullptr, inp(a, I_FLG) + layer * DM, inp(a, I_FLB) + layer * DM, DN_ALPHA, (unsigned long long*)(ws + WS_LNX), (unsigned*)(ws + WS_LNCNT) + (layer * 2 + 1) * 4096};
          pg8::gemm_phase(F.lds, g, So, E, F.tid); }
        if (layer + 1 < 4) GSYNC();
}

__global__ void __launch_bounds__(512, 2) fwd_kernel(Args a) {
    extern __shared__ __attribute__((aligned(16))) unsigned char lds_raw[];
    cg::grid_group grid = cg::this_grid();
    { const int key = __builtin_amdgcn_s_getreg(0x2804) & 63; if ((threadIdx.x & 63) == 0) ((volatile LAS int*)((LAS unsigned char*)lds_raw + WAVE_TBL_OFF))[key] = threadIdx.x >> 6; }
    if (threadIdx.x == 0) { volatile LAS unsigned* st = (volatile LAS unsigned*)((LAS unsigned char*)lds_raw + XB_LDS_OFF); st[0] = 0u; st[1] = 0u; (void)xb_add(&((unsigned*)(a.ws + WS_BAR))[XB_XCNT(xb_xcc_id())], 1u); }
    __syncthreads();

    { PHASE_BEGIN();
      LAS float* tab = (LAS float*)(F.lds + 131072);
      if (F.tid < 128) { float s_, c_; sincos_rev((double)F.tid / 128.0, s_, c_); tab[F.tid] = c_ * 0.08838834764831845f; tab[128 + F.tid] = s_ * 0.08838834764831845f;
          if (bx == 0) { float* ft = (float*)(ws + WS_FTAB); ft[F.tid] = tab[F.tid]; ft[128 + F.tid] = tab[128 + F.tid]; } }
      __syncthreads();
      const int gt = bx * 512 + F.tid, NGT = F.G * 512;
      for (int e = gt; e < S * 32; e += NGT) { const int s = e >> 5, d = e & 31; const float ang = (float)s * ap_->inv_freq[d]; float s_, c_; sincos_rev((double)ang * 0.15915494309189533577, s_, c_); ropeC[e] = c_; ropeS[e] = s_; }
      for (int e = gt; e < 128 * 128; e += NGT) { const int ka = e >> 7, b = e & 127; float s_, c_; sincos_rev((double)(ka * b) / 16384.0, s_, c_); tw[e] = (f32x2){c_, s_}; }
      for (int e = gt; e < 256 * 128; e += NGT) { const int r = e >> 7, n = e & 127; const int idx = ((r & 127) * n) & 127; const float v = (r < 128) ? tab[idx] : tab[128 + idx]; fst[e] = (bf16_t)(cvt_pk_bf16(v, v) & 0xffffu); }
      const float* x = inp(a, I_X);
      for (size_t e = (size_t)gt * 8; e < (size_t)S * DM; e += (size_t)NGT * 8) { const f32x4 v = *(const f32x4*)(x + e), w2 = *(const f32x4*)(x + e + 4);
          const h16x4 h0 = __builtin_convertvector(v, h16x4), h1 = __builtin_convertvector(w2, h16x4); *(h16x8*)((_Float16*)xres + e) = __builtin_shufflevector(h0, h1, 0, 1, 2, 3, 4, 5, 6, 7); }
      convert_even(F, a, 0); convert_ffn(F, a, 0);
#ifdef PROBE_BUILD
      if (bx == 0 && F.tid == 0) *(unsigned*)ws = 0u;
#endif
    }
    if (a.grid < 0) grid.sync();
    GSYNC();

    layer_body<0>(a, lds_raw, grid); layer_body<1>(a, lds_raw, grid); layer_body<2>(a, lds_raw, grid); layer_body<3>(a, lds_raw, grid);
#ifdef PROBE_BUILD
    grid.sync();
    { PHASE_BEGIN(); const unsigned m = *(volatile unsigned*)ws; if (m) { const float dl = 1.0f + (float)m; for (size_t e = (size_t)bx * 512 + F.tid; e < (size_t)S * DM; e += (size_t)F.G * 512) xres[e] += dl; } }
#endif
}

extern "C" void kernel_launch(void* const* d_in, const int* in_sizes, int n_in, void* d_out, int out_size, void* d_ws, size_t ws_size, hipStream_t stream) {
    static int grid = 0;
    if (grid == 0) {
        if (n_in != 21 || out_size != S * DM || ws_size < WS_END) { fprintf(stderr, "kernel_launch: unexpected shapes (n_in %d out %d ws %zu)\n", n_in, out_size, ws_size); grid = -1; return; }
        int dev = 0, cus = 0, per_cu = 0;
        hipGetDevice(&dev); hipDeviceGetAttribute(&cus, hipDeviceAttributeMultiprocessorCount, dev);
        if (hipFuncSetAttribute((const void*)fwd_kernel, hipFuncAttributeMaxDynamicSharedMemorySize, LDS_BYTES) != hipSuccess) { fprintf(stderr, "kernel_launch: hipFuncSetAttribute failed\n"); grid = -1; return; }
        if (hipOccupancyMaxActiveBlocksPerMultiprocessor(&per_cu, (const void*)fwd_kernel, 512, LDS_BYTES) != hipSuccess || per_cu < 1) per_cu = 1;
        (void)hipGetLastError();
        grid = cus * per_cu; grid &= ~7; if (grid <= 0) grid = 8;
    }
    if (grid < 0) return;
    if (hipMemsetAsync(d_ws, 0, 262144, stream) != hipSuccess) { fprintf(stderr, "kernel_launch: memset failed\n"); return; }
    Args a{};
    for (int i = 0; i < 21; ++i) a.in[i] = (const float*)d_in[i];
    a.out = (float*)d_out; a.ws = (unsigned char*)d_ws; a.grid = grid; a.pad = 0;
    for (int d = 0; d < 32; ++d) { const float p = (float)std::pow(10000.0, (double)d / 32.0); a.inv_freq[d] = 1.0f / p; }
    void* args[] = {&a};
    hipError_t e = hipLaunchCooperativeKernel((const void*)fwd_kernel, dim3(grid), dim3(512), args, LDS_BYTES, stream);
    if (e != hipSuccess) fprintf(stderr, "cooperative launch failed: %s (grid %d)\n", hipGetErrorString(e), grid);
}
```
